# Optimizing an MI355X kernel written in HIP

```python
import functools
import jax, jax.numpy as jnp
from jax import lax
import numpy as np

D_MODEL = 1024
BATCH = 16
SEQ = 256
DEPTH = 2
DEC_BATCH = 2
DEC_SEQ = 1024
PAST_LEN = 512

GRID_W = 64
CONV_W = D_MODEL
CONV_K = 3
NA_HEADS = 8
NA_HEAD_DIM = D_MODEL // NA_HEADS
NA_WIDTH = NA_HEADS * NA_HEAD_DIM
NA_MAX_ROWS = 8
NA_COLS = 16
COL_BLOCK = 16
COL_BAND = 2 * COL_BLOCK
FNET_GROUPS = 4
FNET_GROUP_DIM = D_MODEL // FNET_GROUPS
FNET_WIDTH = FNET_GROUPS * FNET_GROUP_DIM
N_BRANCH = 3
IN_SPLITS = (CONV_W, 2 * CONV_W, 3 * CONV_W,
             3 * CONV_W + NA_WIDTH, 3 * CONV_W + 2 * NA_WIDTH, 3 * CONV_W + 3 * NA_WIDTH,
             3 * CONV_W + 3 * NA_WIDTH + FNET_WIDTH)
IN_COLS = 3 * CONV_W + 3 * NA_WIDTH + FNET_WIDTH + N_BRANCH * D_MODEL
PEER_HEADS = 8
PEER_KEYS = 128
PEER_EXPERTS = PEER_KEYS * PEER_KEYS
PEER_KEY_DIM = 128
PEER_TOPK = 16
TOKEN_BLOCK = 128
Q_BLOCK = 128
N_MOD = 6
RMS_EPS = 1e-6
NEG_INF = -1e30

kernel_name = 'hybrid_natten_conv_fnet_peer_diffusion_step'


def rmsnorm(x, g):
    xf = x.astype(jnp.float32)
    y = xf * lax.rsqrt(jnp.mean(xf * xf, axis=-1, keepdims=True) + RMS_EPS)
    return (y * g.astype(jnp.float32)).astype(x.dtype)


def modulate(h, shift, scale):
    return h * (1 + scale) + shift


def short_conv(u, w):
    C = u.shape[-1]
    return lax.conv_general_dilated(u, w[:, None, :].astype(u.dtype), window_strides=(1,),
                                    padding=((CONV_K // 2, CONV_K // 2),),
                                    dimension_numbers=('NWC', 'WIO', 'NWC'),
                                    feature_group_count=C)


def fourier_mix(u):
    B, S, _ = u.shape
    ug = u.reshape(B, S, FNET_GROUPS, FNET_GROUP_DIM).astype(jnp.float32)
    f = jnp.fft.fft2(ug, axes=(1, 3), norm='ortho').real
    return f.reshape(B, S, FNET_WIDTH).astype(u.dtype)


def context_attention(q, k, v):
    B, S, H, dh = q.shape
    nb = S // Q_BLOCK
    scale = dh ** -0.5
    kf = k.astype(jnp.float32)
    vf = v.astype(jnp.float32)
    qb = q.astype(jnp.float32).reshape(B, nb, Q_BLOCK, H, dh).transpose(1, 0, 2, 3, 4)

    def one_block(qi):
        s = jnp.einsum('bqhd,bkhd->bhqk', qi, kf) * scale
        p = jax.nn.softmax(s, axis=-1)
        return jnp.einsum('bhqk,bkhd->bqhd', p, vf)

    o = lax.map(one_block, qb)
    return o.transpose(1, 0, 2, 3, 4).reshape(B, S, H * dh).astype(q.dtype)


def neighbourhood_attention(q, k, v, k_ctx, v_ctx, rpb):
    B, S, H, dh = q.shape
    rows = S // GRID_W
    kr = min(NA_MAX_ROWS, rows)
    ncb = GRID_W // COL_BLOCK
    scale = dh ** -0.5
    r = jnp.arange(rows)
    r0 = jnp.clip(r - kr // 2, 0, rows - kr)
    row_idx = r0[:, None] + jnp.arange(kr)
    j = jnp.arange(ncb)
    b0 = jnp.clip(j * COL_BLOCK - COL_BLOCK // 2, 0, GRID_W - COL_BAND)
    col_idx = b0[:, None] + jnp.arange(COL_BAND)
    qcol = j[:, None] * COL_BLOCK + jnp.arange(COL_BLOCK)
    c0 = jnp.clip(qcol - NA_COLS // 2, 0, GRID_W - NA_COLS)
    kcol = col_idx[:, None, :]
    in_win = (kcol >= c0[..., None]) & (kcol < c0[..., None] + NA_COLS)
    dr = row_idx - r[:, None] + (NA_MAX_ROWS - 1)
    dc = jnp.clip(kcol - qcol[..., None] + (NA_COLS - 1), 0, 2 * NA_COLS - 2)
    bias = rpb[:, dr[:, None, None, :, None], dc[None, :, :, None, :]]
    bias = jnp.transpose(bias, (1, 2, 3, 0, 4, 5)).astype(jnp.float32)
    bias = jnp.where(in_win[None, :, :, None, None, :], bias, NEG_INF)

    qg = q.astype(jnp.float32).reshape(B, rows, ncb, COL_BLOCK, H, dh)
    gather = lambda t: t.astype(jnp.float32).reshape(B, rows, GRID_W, H, dh)[
        :, row_idx[:, :, None, None], col_idx[None, None, :, :]]
    kg = gather(k)
    vg = gather(v)
    kc = k_ctx.astype(jnp.float32)
    vc = v_ctx.astype(jnp.float32)
    s_loc = jnp.einsum('brjqhd,brkjchd->brjqhkc', qg, kg) * scale + bias[None]
    s_ctx = jnp.einsum('brjqhd,blhd->brjqhl', qg, kc) * scale
    n_loc = kr * COL_BAND
    s = jnp.concatenate([s_loc.reshape(s_loc.shape[:5] + (n_loc,)), s_ctx], axis=-1)
    p = jax.nn.softmax(s, axis=-1)
    p_loc = p[..., :n_loc].reshape(s_loc.shape)
    p_ctx = p[..., n_loc:]
    o = (jnp.einsum('brjqhkc,brkjchd->brjqhd', p_loc, vg)
         + jnp.einsum('brjqhl,blhd->brjqhd', p_ctx, vc))
    return o.reshape(B, S, H * dh).astype(q.dtype)


def peer_ffn(h, w_pq, sub_keys, peer_u, peer_v):
    B, S, D = h.shape
    T = B * S
    hf = h.reshape(T, D)
    q = (hf @ w_pq).reshape(T, PEER_HEADS, 2, PEER_KEY_DIM)
    s = jnp.einsum('thpd,hpnd->thpn', q.astype(jnp.float32), sub_keys.astype(jnp.float32))
    s1, i1 = lax.top_k(s[:, :, 0], PEER_TOPK)
    s2, i2 = lax.top_k(s[:, :, 1], PEER_TOPK)
    cand_s = (s1[..., :, None] + s2[..., None, :]).reshape(T, PEER_HEADS, PEER_TOPK * PEER_TOPK)
    cand_i = (i1[..., :, None] * PEER_KEYS + i2[..., None, :]).reshape(T, PEER_HEADS, PEER_TOPK * PEER_TOPK)
    top_s, pos = lax.top_k(cand_s, PEER_TOPK)
    e_idx = jnp.take_along_axis(cand_i, pos, axis=-1).reshape(T, PEER_HEADS * PEER_TOPK)
    gate = jax.nn.softmax(top_s, axis=-1).reshape(T, PEER_HEADS * PEER_TOPK)
    nb = T // TOKEN_BLOCK
    HK = PEER_HEADS * PEER_TOPK

    def one_block(args):
        xb, ib, gb = args
        ub = jnp.take(peer_u, ib, axis=0).astype(jnp.float32)
        a = jnp.einsum('tkd,td->tk', ub, xb.astype(jnp.float32))
        a = jax.nn.gelu(a, approximate=False) * gb
        vb = jnp.take(peer_v, ib, axis=0).astype(jnp.float32)
        return jnp.einsum('tk,tkd->td', a, vb).astype(xb.dtype)

    out = lax.map(one_block, (hf.reshape(nb, TOKEN_BLOCK, D),
                              e_idx.reshape(nb, TOKEN_BLOCK, HK),
                              gate.reshape(nb, TOKEN_BLOCK, HK)))
    return out.reshape(B, S, D)


def trunk_layer(x, mod, lp, attend):
    (w_in, conv_w, w_conv_out, w_attn_out, w_four_out, w_o,
     g_mix, g_ffn, w_pq, sub_keys, peer_u, peer_v) = lp
    shift1, scale1, gate1, shift2, scale2, gate2 = mod
    B, S, _ = x.shape
    h = modulate(rmsnorm(x, g_mix), shift1, scale1)
    z = h @ w_in
    cb, cc, cx, q, k, v, f, gl = jnp.split(z, IN_SPLITS, axis=-1)
    y_conv = (cb * short_conv(cc * cx, conv_w)) @ w_conv_out
    q = q.reshape(B, S, NA_HEADS, NA_HEAD_DIM)
    k = k.reshape(B, S, NA_HEADS, NA_HEAD_DIM)
    v = v.reshape(B, S, NA_HEADS, NA_HEAD_DIM)
    y_att = attend(q, k, v) @ w_attn_out
    y_four = fourier_mix(f) @ w_four_out
    g = jax.nn.sigmoid(gl.astype(jnp.float32)).astype(x.dtype).reshape(B, S, N_BRANCH, D_MODEL)
    merged = g[:, :, 0] * y_conv + g[:, :, 1] * y_att + g[:, :, 2] * y_four
    x = x + gate1 * (merged @ w_o)
    h = modulate(rmsnorm(x, g_ffn), shift2, scale2)
    x = x + gate2 * peer_ffn(h, w_pq, sub_keys, peer_u, peer_v)
    return x, k, v


def setup_inputs(seed: int = 0) -> dict:
    key = jax.random.key(seed)
    ks = jax.random.split(key, 24)
    nrm = lambda k, shape, s: jax.random.normal(k, shape, jnp.float32) * s
    L = DEPTH
    return {
        'x_prompt': nrm(ks[0], (BATCH, SEQ, D_MODEL), 1.0),
        'x_sample': nrm(ks[1], (DEC_BATCH, DEC_SEQ, D_MODEL), 1.0),
        'cache_k': nrm(ks[2], (DEC_BATCH, DEPTH, PAST_LEN, NA_HEADS, NA_HEAD_DIM), 1.0),
        'cache_v': nrm(ks[3], (DEC_BATCH, DEPTH, PAST_LEN, NA_HEADS, NA_HEAD_DIM), 1.0),
        'c': nrm(ks[4], (DEC_BATCH, D_MODEL), 1.0),
        'c_ctx': nrm(ks[5], (D_MODEL,), 1.0),
        'w_in': nrm(ks[6], (L, D_MODEL, IN_COLS), D_MODEL ** -0.5),
        'conv_w': nrm(ks[7], (L, CONV_K, CONV_W), CONV_K ** -0.5),
        'w_conv_out': nrm(ks[8], (L, CONV_W, D_MODEL), CONV_W ** -0.5),
        'rpb': nrm(ks[9], (L, NA_HEADS, 2 * NA_MAX_ROWS - 1, 2 * NA_COLS - 1), 0.1),
        'w_attn_out': nrm(ks[10], (L, NA_WIDTH, D_MODEL), NA_WIDTH ** -0.5),
        'w_four_out': nrm(ks[11], (L, FNET_WIDTH, D_MODEL), FNET_WIDTH ** -0.5),
        'w_o': nrm(ks[12], (L, D_MODEL, D_MODEL), D_MODEL ** -0.5),
        'g_mix': 1.0 + nrm(ks[13], (L, D_MODEL), 0.02),
        'g_ffn': 1.0 + nrm(ks[14], (L, D_MODEL), 0.02),
        'w_mod': nrm(ks[15], (L, D_MODEL, N_MOD * D_MODEL), D_MODEL ** -0.5),
        'b_mod': nrm(ks[16], (L, N_MOD * D_MODEL), 0.02),
        'w_pq': nrm(ks[17], (L, D_MODEL, PEER_HEADS * 2 * PEER_KEY_DIM), D_MODEL ** -0.5),
        'sub_keys': nrm(ks[18], (L, PEER_HEADS, 2, PEER_KEYS, PEER_KEY_DIM), PEER_KEY_DIM ** -0.5),
        'peer_u': nrm(ks[19], (L, PEER_EXPERTS, D_MODEL), D_MODEL ** -0.5),
        'peer_v': nrm(ks[20], (L, PEER_EXPERTS, D_MODEL), (PEER_HEADS * PEER_TOPK) ** -0.5),
        'g_final': 1.0 + nrm(ks[21], (D_MODEL,), 0.02),
    }


def reference(x_prompt, x_sample, cache_k, cache_v, c, c_ctx, w_in, conv_w, w_conv_out, rpb,
              w_attn_out, w_four_out, w_o, g_mix, g_ffn, w_mod, b_mod, w_pq, sub_keys,
              peer_u, peer_v, g_final):
    xp = x_prompt
    xs = x_sample
    ctx_k, ctx_v = [], []
    for l in range(DEPTH):
        lp = (w_in[l], conv_w[l], w_conv_out[l], w_attn_out[l], w_four_out[l], w_o[l],
              g_mix[l], g_ffn[l], w_pq[l], sub_keys[l], peer_u[l], peer_v[l])
        mod_ctx = (jax.nn.silu(c_ctx) @ w_mod[l] + b_mod[l]).reshape(N_MOD, 1, 1, D_MODEL)
        mod_lat = (jax.nn.silu(c) @ w_mod[l] + b_mod[l]).reshape(-1, N_MOD, D_MODEL)
        mod_lat = mod_lat.transpose(1, 0, 2)[:, :, None, :]
        xp, k_l, v_l = trunk_layer(xp, mod_ctx, lp, context_attention)
        ctx_k.append(k_l)
        ctx_v.append(v_l)
        attend_lat = functools.partial(neighbourhood_attention, k_ctx=cache_k[:, l],
                                       v_ctx=cache_v[:, l], rpb=rpb[l])
        xs, _, _ = trunk_layer(xs, mod_lat, lp, attend_lat)
    y_prompt = rmsnorm(xp, g_final)
    y_sample = rmsnorm(xs, g_final)
    new_cache_k = jnp.stack(ctx_k, axis=1)
    new_cache_v = jnp.stack(ctx_v, axis=1)
    return (y_prompt, y_sample, new_cache_k, new_cache_v)
```

```cpp
#include <hip/hip_runtime.h>
#include <hip/hip_cooperative_groups.h>
#include <cstdio>
#include <cstdint>
namespace cg = cooperative_groups;

#ifndef MK_COOP
#define MK_COOP 1
#endif

typedef unsigned short bf16_t;
typedef short bf16x8 __attribute__((ext_vector_type(8)));
typedef float f32x4 __attribute__((ext_vector_type(4)));
typedef unsigned u32x4 __attribute__((ext_vector_type(4)));
typedef unsigned u32x2 __attribute__((ext_vector_type(2)));

constexpr int T = 6144, TC = 4096, D = 1024, INC = 10240;
constexpr int NPH = 18;
constexpr float RMS_EPS = 1e-6f;

constexpr size_t SZ_TD2 = (size_t)T * D * 2;
constexpr size_t OFF_WIN = 0;
constexpr size_t OFF_W4 = OFF_WIN + 2ull * INC * D * 2;
constexpr size_t OFF_WPQ = OFF_W4 + 2ull * 4 * D * D * 2;
constexpr size_t OFF_SK = OFF_WPQ + 2ull * 2048 * D * 2;
constexpr size_t OFF_PU = OFF_SK + 2ull * 8 * 2 * 128 * 128 * 2;
constexpr size_t OFF_PV = OFF_PU + 2ull * 16384 * D * 2;
constexpr size_t OFF_MOD = OFF_PV + 2ull * 16384 * D * 2;
constexpr size_t OFF_D1 = OFF_MOD + 2 * 3 * 6 * 1024 * 4;
constexpr size_t OFF_A2C = OFF_D1 + 512 * 256 * 2;
constexpr size_t OFF_A2L = OFF_A2C + 256 * 512 * 2;
constexpr size_t OFF_CK = OFF_A2L + 1024 * 2048 * 2;
constexpr size_t OFF_CVT = OFF_CK + 2 * 2 * 512 * 1024 * 2;
constexpr size_t OFF_X = OFF_CVT + 2 * 2 * 512 * 1024 * 2;
constexpr size_t OFF_H = OFF_X + (size_t)T * D * 4;
constexpr size_t OFF_Z = OFF_H + SZ_TD2;
constexpr size_t OFF_VT = OFF_Z + (size_t)T * INC * 2;
constexpr size_t OFF_ACONV = OFF_VT + SZ_TD2;
constexpr size_t OFF_ATT = OFF_ACONV + SZ_TD2;
constexpr size_t OFF_FOUR = OFF_ATT + SZ_TD2;
constexpr size_t OFF_PQT = OFF_FOUR + SZ_TD2;
constexpr size_t OFF_MERGED = OFF_PQT + 2 * SZ_TD2;
constexpr size_t OFF_Q = OFF_MERGED + SZ_TD2;
constexpr size_t OFF_EIDX = OFF_Q + 2 * SZ_TD2;
constexpr size_t OFF_GATE = OFF_EIDX + (size_t)T * 128 * 4;
constexpr size_t OFF_BAR = OFF_GATE + (size_t)T * 128 * 4;
constexpr size_t BAR_BYTES = 16384;
constexpr size_t WS_END = OFF_BAR + BAR_BYTES;

struct Params {
    const float *x_prompt, *x_sample, *cache_k, *cache_v, *c, *c_ctx, *w_in, *conv_w, *w_conv_out, *rpb, *w_attn_out, *w_four_out, *w_o,
        *g_mix, *g_ffn, *w_mod, *b_mod, *w_pq, *sub_keys, *peer_u, *peer_v, *g_final;
    float* out;
    unsigned char* ws;
};

typedef __bf16 bf16x2_t __attribute__((ext_vector_type(2)));
typedef float f32x2_t __attribute__((ext_vector_type(2)));
__device__ __forceinline__ unsigned pk2(float lo, float hi) { const bf16x2_t r = __builtin_convertvector((f32x2_t){lo, hi}, bf16x2_t); return __builtin_bit_cast(unsigned, r); }
__device__ __forceinline__ u32x2 pk4(f32x4 v) { u32x2 r; r.x = pk2(v[0], v[1]); r.y = pk2(v[2], v[3]); return r; }
__device__ __forceinline__ float bf_lo(unsigned w) { return __uint_as_float(w << 16); }
__device__ __forceinline__ float bf_hi(unsigned w) { return __uint_as_float(w & 0xffff0000u); }
__device__ __forceinline__ float shfl_idx(float v, int src_lane) { return __int_as_float(__builtin_amdgcn_ds_bpermute(src_lane << 2, __float_as_int(v))); }
__device__ __forceinline__ int dpp_xor1(int v) { return __builtin_amdgcn_update_dpp(v, v, 0xB1, 0xF, 0xF, true); }
__device__ __forceinline__ int dpp_xor2(int v) { return __builtin_amdgcn_update_dpp(v, v, 0x4E, 0xF, 0xF, true); }
__device__ __forceinline__ int dpp_xor8(int v) { return __builtin_amdgcn_update_dpp(v, v, 0x128, 0xF, 0xF, true); }
template <int M> __device__ __forceinline__ float shfl_xor_c(float v, int lane) {
    if (M == 8) return __int_as_float(dpp_xor8(__float_as_int(v)));
    if (M == 1) return __int_as_float(dpp_xor1(__float_as_int(v)));
    if (M == 2) return __int_as_float(dpp_xor2(__float_as_int(v)));
    return shfl_idx(v, lane ^ M);
}
#define SHFL_XOR(v, m) shfl_xor_c<(m)>((v), lane)
__device__ __forceinline__ float wave_sum(float v, int lane) {
    v += SHFL_XOR(v, 32); v += SHFL_XOR(v, 16); v += SHFL_XOR(v, 8); v += SHFL_XOR(v, 4); v += SHFL_XOR(v, 2); v += SHFL_XOR(v, 1);
    return v;
}
__device__ __forceinline__ int tok_set(int t) { return t < TC ? 0 : 1 + ((t - TC) >> 10); }
__device__ __forceinline__ unsigned f2key(float f) { unsigned u = __float_as_uint(f); return (u & 0x80000000u) ? ~u : (u | 0x80000000u); }
__device__ __forceinline__ float key2f(unsigned k) { unsigned u = (k & 0x80000000u) ? (k & 0x7fffffffu) : ~k; return __uint_as_float(u); }

constexpr int LROW = 64;
constexpr int LTILE = 128 * LROW;
constexpr int SMEM_BYTES = 4 * LTILE * 2;

template <int MR, int DEEP = 1>
__device__ __forceinline__ void gemm_tile(const bf16_t* __restrict__ Act, int lda, const bf16_t* __restrict__ W, int ldw, int K,
                                          f32x4 (&acc)[4][MR / 32], bf16_t* smem, const int TID) {
    constexpr int JT = MR / 32, AI = MR / 32;
    const int tid = TID, lane = tid & 63, wave = tid >> 6, wr = wave >> 1, wc = wave & 1, l15 = lane & 15, g = lane >> 4;
    const int lrow = tid >> 3, lkc = (tid & 7) * 8;
    const int skc = ((tid & 7) ^ ((lrow >> 1) & 7)) * 8;
    const int rsw = (l15 >> 1) & 7;
    const bf16_t* ap = Act + (size_t)lrow * lda + lkc;
    const bf16_t* wp = W + (size_t)lrow * ldw + lkc;
    const int nk = K >> 6;
#define GT_LOAD(RA, RW, KT) do { const int k0_ = (KT) << 6; \
        _Pragma("unroll") for (int i = 0; i < AI; ++i) RA[i] = *(const u32x4*)(ap + (size_t)(32 * i) * lda + k0_); \
        _Pragma("unroll") for (int i = 0; i < 4; ++i) RW[i] = *(const u32x4*)(wp + (size_t)(32 * i) * ldw + k0_); } while (0)
#define GT_STORE(RA, RW, BUF) do { bf16_t* da_ = smem + (BUF) * 2 * LTILE; bf16_t* dw_ = da_ + LTILE; \
        _Pragma("unroll") for (int i = 0; i < AI; ++i) *(u32x4*)(da_ + (lrow + 32 * i) * LROW + skc) = RA[i]; \
        _Pragma("unroll") for (int i = 0; i < 4; ++i) *(u32x4*)(dw_ + (lrow + 32 * i) * LROW + skc) = RW[i]; } while (0)
#define GT_COMPUTE(BUF) do { const bf16_t* sa_ = smem + (BUF) * 2 * LTILE; const bf16_t* sw_ = sa_ + LTILE; \
        _Pragma("unroll") for (int ks = 0; ks < 2; ++ks) { bf16x8 af[JT], wf[4]; \
            _Pragma("unroll") for (int j = 0; j < JT; ++j) af[j] = *(const bf16x8*)(sa_ + (wr * (MR / 2) + j * 16 + l15) * LROW + ((ks * 4 + g) ^ rsw) * 8); \
            _Pragma("unroll") for (int i = 0; i < 4; ++i) wf[i] = *(const bf16x8*)(sw_ + (wc * 64 + i * 16 + l15) * LROW + ((ks * 4 + g) ^ rsw) * 8); \
            __builtin_amdgcn_s_setprio(1); \
            _Pragma("unroll") for (int i = 0; i < 4; ++i) _Pragma("unroll") for (int j = 0; j < JT; ++j) acc[i][j] = __builtin_amdgcn_mfma_f32_16x16x32_bf16(wf[i], af[j], acc[i][j], 0, 0, 0); \
            __builtin_amdgcn_s_setprio(0); } } while (0)
    u32x4 ra[AI], rw[4];
    GT_LOAD(ra, rw, 0);
    GT_STORE(ra, rw, 0);
    __syncthreads();
    if (DEEP == 2) {
        u32x4 rb[AI], rv[4], rc[AI], rx[4];
        GT_LOAD(rb, rv, 1);
        if (2 < nk) GT_LOAD(rc, rx, 2);
        for (int kt = 0; kt < nk; kt += 3) {
            if (kt + 3 < nk) GT_LOAD(ra, rw, kt + 3);
            GT_COMPUTE(kt & 1);
            if (kt + 1 < nk) GT_STORE(rb, rv, (kt + 1) & 1);
            __syncthreads();
            if (kt + 1 < nk) {
                if (kt + 4 < nk) GT_LOAD(rb, rv, kt + 4);
                GT_COMPUTE((kt + 1) & 1);
                if (kt + 2 < nk) GT_STORE(rc, rx, kt & 1);
                __syncthreads();
            }
            if (kt + 2 < nk) {
                if (kt + 5 < nk) GT_LOAD(rc, rx, kt + 5);
                GT_COMPUTE(kt & 1);
                if (kt + 3 < nk) GT_STORE(ra, rw, (kt + 1) & 1);
                __syncthreads();
            }
        }
    } else if (DEEP == 1) {
        u32x4 rb[AI], rv[4];
        GT_LOAD(ra, rw, 1);
        for (int kt = 0; kt < nk; kt += 2) {
            if (kt + 2 < nk) GT_LOAD(rb, rv, kt + 2);
            GT_COMPUTE(0);
            GT_STORE(ra, rw, 1);
            __syncthreads();
            if (kt + 3 < nk) GT_LOAD(ra, rw, kt + 3);
            GT_COMPUTE(1);
            if (kt + 2 < nk) GT_STORE(rb, rv, 0);
            __syncthreads();
        }
    } else {
        for (int kt = 0; kt < nk; ++kt) {
            const bool more = (kt + 1) < nk;
            if (more) GT_LOAD(ra, rw, kt + 1);
            GT_COMPUTE(kt & 1);
            if (more) GT_STORE(ra, rw, (kt + 1) & 1);
            __syncthreads();
        }
    }
#undef GT_LOAD
#undef GT_STORE
#undef GT_COMPUTE
}
template <int MR>
__device__ __forceinline__ void gemm_tile_lds_act(const bf16_t* __restrict__ W, int ldw, f32x4 (&acc)[4][MR / 32], bf16_t* smem, const int TID) {
    constexpr int JT = MR / 32;
    const int tid = TID, lane = tid & 63, wave = tid >> 6, wr = wave >> 1, wc = wave & 1, l15 = lane & 15, g = lane >> 4;
    const int lrow = tid >> 3, lkc = (tid & 7) * 8;
    const int skc = ((tid & 7) ^ ((lrow >> 1) & 7)) * 8;
    const int rsw = (l15 >> 1) & 7;
    const bf16_t* wp = W + (size_t)lrow * ldw + lkc;
#pragma unroll
    for (int kt = 0; kt < 2; ++kt) {
        u32x4 rw[4];
#pragma unroll
        for (int i = 0; i < 4; ++i) rw[i] = *(const u32x4*)(wp + (size_t)(32 * i) * ldw + kt * 64);
        bf16_t* dw = smem + kt * 2 * LTILE + LTILE;
#pragma unroll
        for (int i = 0; i < 4; ++i) *(u32x4*)(dw + (lrow + 32 * i) * LROW + skc) = rw[i];
    }
    __syncthreads();
#pragma unroll
    for (int kt = 0; kt < 2; ++kt) {
        const bf16_t* sa = smem + kt * 2 * LTILE;
        const bf16_t* sw = sa + LTILE;
#pragma unroll
        for (int ks = 0; ks < 2; ++ks) {
            bf16x8 af[JT], wf[4];
#pragma unroll
            for (int j = 0; j < JT; ++j) af[j] = *(const bf16x8*)(sa + (wr * (MR / 2) + j * 16 + l15) * LROW + ((ks * 4 + g) ^ rsw) * 8);
#pragma unroll
            for (int i = 0; i < 4; ++i) wf[i] = *(const bf16x8*)(sw + (wc * 64 + i * 16 + l15) * LROW + ((ks * 4 + g) ^ rsw) * 8);
#pragma unroll
            for (int i = 0; i < 4; ++i)
#pragma unroll
                for (int j = 0; j < JT; ++j) acc[i][j] = __builtin_amdgcn_mfma_f32_16x16x32_bf16(wf[i], af[j], acc[i][j], 0, 0, 0);
        }
    }
    __syncthreads();
}
template <int JT>
__device__ __forceinline__ void zero_acc(f32x4 (&acc)[4][JT]) {
#pragma unroll
    for (int i = 0; i < 4; ++i)
#pragma unroll
        for (int j = 0; j < JT; ++j) acc[i][j] = (f32x4){0.f, 0.f, 0.f, 0.f};
}
#define TILE_IDS const int lane = TID & 63, wave = TID >> 6, wr = wave >> 1, wc = wave & 1, l15 = lane & 15, g = lane >> 4; (void)lane; (void)wr; (void)wc; (void)l15; (void)g;

struct TrItem { const float* src; bf16_t* dst; int N, k0, n0; };
__device__ __forceinline__ TrItem tr_decode(const Params& p, int item) {
    const int l = item >> 12; int r = item & 4095;
    const float* src; bf16_t* dst; int N;
    bf16_t* w4 = (bf16_t*)(p.ws + OFF_W4) + (size_t)l * 4 * D * D;
    if (r < 2560) { src = p.w_in + (size_t)l * D * INC; dst = (bf16_t*)(p.ws + OFF_WIN) + (size_t)l * INC * D; N = INC; }
    else if (r < 2816) { r -= 2560; src = p.w_conv_out + (size_t)l * D * D; dst = w4; N = D; }
    else if (r < 3072) { r -= 2816; src = p.w_attn_out + (size_t)l * D * D; dst = w4 + (size_t)D * D; N = D; }
    else if (r < 3328) { r -= 3072; src = p.w_four_out + (size_t)l * D * D; dst = w4 + (size_t)2 * D * D; N = D; }
    else if (r < 3584) { r -= 3328; src = p.w_o + (size_t)l * D * D; dst = w4 + (size_t)3 * D * D; N = D; }
    else { r -= 3584; src = p.w_pq + (size_t)l * D * 2048; dst = (bf16_t*)(p.ws + OFF_WPQ) + (size_t)l * 2048 * D; N = 2048; }
    const int ntn = N >> 6, kt = r / ntn, nt = r - kt * ntn;
    TrItem t; t.src = src; t.dst = dst; t.N = N; t.k0 = kt * 64; t.n0 = nt * 64; return t;
}
__device__ __forceinline__ void transpose3(const Params& p, int base, int nitems, float* tiles, const int TID) {
    const int tid = TID, r = tid >> 4, c4 = (tid & 15) * 4;
    float4 v[3][4];
    TrItem t[3];
#pragma unroll
    for (int q = 0; q < 3; ++q) {
        t[q] = tr_decode(p, (base + q) < nitems ? (base + q) : base);
#pragma unroll
        for (int i = 0; i < 4; ++i) v[q][i] = *(const float4*)(t[q].src + (size_t)(t[q].k0 + r + 16 * i) * t[q].N + t[q].n0 + c4);
    }
#pragma unroll
    for (int q = 0; q < 3; ++q)
#pragma unroll
        for (int i = 0; i < 4; ++i) { float* tp = tiles + q * (64 * 65) + (r + 16 * i) * 65 + c4; tp[0] = v[q][i].x; tp[1] = v[q][i].y; tp[2] = v[q][i].z; tp[3] = v[q][i].w; }
    __syncthreads();
#pragma unroll
    for (int q = 0; q < 3; ++q) {
        if (base + q < nitems) {
#pragma unroll
            for (int i = 0; i < 2; ++i) {
                const int cid = tid + 256 * i, n = cid >> 3, kc = cid & 7;
                const float* sp = tiles + q * (64 * 65) + (kc * 8) * 65 + n;
                u32x4 o; o.x = pk2(sp[0], sp[65]); o.y = pk2(sp[2 * 65], sp[3 * 65]); o.z = pk2(sp[4 * 65], sp[5 * 65]); o.w = pk2(sp[6 * 65], sp[7 * 65]);
                *(u32x4*)(t[q].dst + (size_t)(t[q].n0 + n) * D + t[q].k0 + kc * 8) = o;
            }
        }
    }
    __syncthreads();
}

__device__ __forceinline__ void cvt8(const float* __restrict__ src, bf16_t* __restrict__ dst, size_t i8) {
    const float4 a = *(const float4*)(src + i8 * 8), b = *(const float4*)(src + i8 * 8 + 4);
    u32x4 o; o.x = pk2(a.x, a.y); o.y = pk2(a.z, a.w); o.z = pk2(b.x, b.y); o.w = pk2(b.z, b.w);
    *(u32x4*)(dst + i8 * 8) = o;
}

typedef float f32x2v __attribute__((ext_vector_type(2)));
__device__ __forceinline__ unsigned fp8x4(float a, float b, float c, float d) {
    int w = __builtin_amdgcn_cvt_pk_fp8_f32(a, b, 0, false);
    w = __builtin_amdgcn_cvt_pk_fp8_f32(c, d, w, true);
    return (unsigned)w;
}
__device__ __forceinline__ void cvt16_fp8(const float* __restrict__ src, unsigned char* __restrict__ dst, size_t i16, float sc) {
    const float4 a = *(const float4*)(src + i16 * 16), b = *(const float4*)(src + i16 * 16 + 4), c = *(const float4*)(src + i16 * 16 + 8), d = *(const float4*)(src + i16 * 16 + 12);
    u32x4 o; o.x = fp8x4(a.x * sc, a.y * sc, a.z * sc, a.w * sc); o.y = fp8x4(b.x * sc, b.y * sc, b.z * sc, b.w * sc);
    o.z = fp8x4(c.x * sc, c.y * sc, c.z * sc, c.w * sc); o.w = fp8x4(d.x * sc, d.y * sc, d.z * sc, d.w * sc);
    *(u32x4*)(dst + i16 * 16) = o;
}

__device__ __forceinline__ void phase_setup(const Params& p, unsigned char* smem_raw, const int TID) {
    const int tid = TID;
    const size_t gtid = (size_t)blockIdx.x * 256 + tid, gsz = (size_t)gridDim.x * 256;
    float* fs = (float*)smem_raw;
    float* modv = (float*)(p.ws + OFF_MOD);
    for (int item = blockIdx.x; item < 2 * 192; item += gridDim.x) {
        const int l = item / 192, chunk = item - l * 192;
        for (int idx = tid; idx < 3072; idx += 256) {
            const int set = idx >> 10, k = idx & 1023;
            const float cv = set == 0 ? p.c_ctx[k] : p.c[(set - 1) * 1024 + k];
            fs[idx] = cv / (1.f + __expf(-cv));
        }
        __syncthreads();
        const int kq = tid >> 5, cl = tid & 31, n = chunk * 32 + cl;
        const float* wm = p.w_mod + (size_t)l * 1024 * 6144 + n;
        float a0 = 0.f, a1 = 0.f, a2 = 0.f;
#pragma unroll 32
        for (int k = kq * 128; k < kq * 128 + 128; ++k) {
            const float w = wm[(size_t)k * 6144];
            a0 += fs[k] * w; a1 += fs[1024 + k] * w; a2 += fs[2048 + k] * w;
        }
        float* red = fs + 3072;
        red[(kq * 3 + 0) * 32 + cl] = a0; red[(kq * 3 + 1) * 32 + cl] = a1; red[(kq * 3 + 2) * 32 + cl] = a2;
        __syncthreads();
        if (tid < 96) {
            const int set = tid >> 5;
            float sacc = 0.f;
#pragma unroll
            for (int q = 0; q < 8; ++q) sacc += red[(q * 3 + set) * 32 + cl];
            modv[((size_t)l * 3 + set) * 6144 + n] = sacc + p.b_mod[(size_t)l * 6144 + n];
        }
        __syncthreads();
    }
    for (int base = blockIdx.x * 3; base < 8192; base += gridDim.x * 3) transpose3(p, base, 8192, fs, TID);
    {
        const size_t n_p8 = 2ull * 16384 * D / 16;
#pragma unroll 2
        for (size_t i = gtid; i < n_p8; i += gsz) { cvt16_fp8(p.peer_u, p.ws + OFF_PU, i, 64.f); cvt16_fp8(p.peer_v, p.ws + OFF_PV, i, 16.f); }
        const size_t n_sk = 2ull * 8 * 2 * 128 * 128 / 8;
        for (size_t i = gtid; i < n_sk; i += gsz) cvt8(p.sub_keys, (bf16_t*)(p.ws + OFF_SK), i);
        const size_t n_ck = 2ull * 2 * 512 * 1024 / 8;
        for (size_t i = gtid; i < n_ck; i += gsz) cvt8(p.cache_k, (bf16_t*)(p.ws + OFF_CK), i);
        bf16_t* cvt = (bf16_t*)(p.ws + OFF_CVT);
        for (size_t i = gtid; i < n_ck; i += gsz) {
            const int hd = (int)(i & 1023), p8 = (int)((i >> 10) & 63), bl = (int)(i >> 16);
            const float* s = p.cache_v + ((size_t)bl * 512 + p8 * 8) * 1024 + hd;
            u32x4 o; o.x = pk2(s[0], s[1024]); o.y = pk2(s[2048], s[3072]); o.z = pk2(s[4096], s[5120]); o.w = pk2(s[6144], s[7168]);
            *(u32x4*)(cvt + ((size_t)bl * 1024 + hd) * 512 + p8 * 8) = o;
        }
    }
    {
        bf16_t* d1 = (bf16_t*)(p.ws + OFF_D1);
        for (size_t i = gtid; i < 512 * 256; i += gsz) {
            const int cc = (int)(i & 255), m = (int)(i >> 8), pq = m >> 8, cp = m & 255, idx = (cc * cp) & 255;
            const float ang = (float)idx * (1.f / 128.f);
            const float v = (pq ? sinpif(ang) : cospif(ang)) * (1.f / 16.f);
            d1[i] = (bf16_t)(pk2(v, 0.f) & 0xffffu);
        }
        bf16_t* a2c = (bf16_t*)(p.ws + OFF_A2C);
        for (size_t i = gtid; i < 256 * 512; i += gsz) {
            const int k = (int)(i & 511), sp = (int)(i >> 9), pq = k >> 8, s = k & 255, idx = (s * sp) & 255;
            const float ang = (float)idx * (1.f / 128.f);
            const float v = (pq ? -sinpif(ang) : cospif(ang)) * (1.f / 16.f);
            a2c[i] = (bf16_t)(pk2(v, 0.f) & 0xffffu);
        }
        bf16_t* a2l = (bf16_t*)(p.ws + OFF_A2L);
        for (size_t i = gtid; i < 1024 * 2048; i += gsz) {
            const int k = (int)(i & 2047), sp = (int)(i >> 11), pq = k >> 10, s = k & 1023, idx = (s * sp) & 1023;
            const float ang = (float)idx * (1.f / 512.f);
            const float v = (pq ? -sinpif(ang) : cospif(ang)) * (1.f / 32.f);
            a2l[i] = (bf16_t)(pk2(v, 0.f) & 0xffffu);
        }
    }
}

__device__ __forceinline__ const float* x_in_row(const Params& p, int t) { return t < TC ? p.x_prompt + (size_t)t * D : p.x_sample + (size_t)(t - TC) * D; }
__device__ __forceinline__ void phase_norm(const Params& p, const float* __restrict__ gw, const float* __restrict__ modl, int shift_i, int scale_i, const int TID, bool from_inputs = false) {
    const int lane = TID & 63, wave = TID >> 6;
    const float* x = (const float*)(p.ws + OFF_X);
    bf16_t* h = (bf16_t*)(p.ws + OFF_H);
    for (int tok = blockIdx.x * 4 + wave; tok < T; tok += gridDim.x * 4) {
        float4 v[4]; float ss = 0.f;
        const float* xr = from_inputs ? x_in_row(p, tok) : x + (size_t)tok * D;
#pragma unroll
        for (int i = 0; i < 4; ++i) { v[i] = *(const float4*)(xr + i * 256 + lane * 4); ss += v[i].x * v[i].x + v[i].y * v[i].y + v[i].z * v[i].z + v[i].w * v[i].w; }
        ss = wave_sum(ss, lane);
        const float rstd = rsqrtf(ss * (1.f / D) + RMS_EPS);
        const float* ms = modl + (size_t)tok_set(tok) * 6144;
#pragma unroll
        for (int i = 0; i < 4; ++i) {
            const int n = i * 256 + lane * 4;
            const float4 gg = *(const float4*)(gw + n), sc = *(const float4*)(ms + scale_i * 1024 + n), sh = *(const float4*)(ms + shift_i * 1024 + n);
            f32x4 y;
            y[0] = v[i].x * rstd * gg.x * (1.f + sc.x) + sh.x; y[1] = v[i].y * rstd * gg.y * (1.f + sc.y) + sh.y;
            y[2] = v[i].z * rstd * gg.z * (1.f + sc.z) + sh.z; y[3] = v[i].w * rstd * gg.w * (1.f + sc.w) + sh.w;
            *(u32x2*)(h + (size_t)tok * D + n) = pk4(y);
        }
    }
}

__device__ __forceinline__ void phase_g1(const Params& p, int l, bf16_t* smem, const int TID) {
    TILE_IDS
    const bf16_t* h = (const bf16_t*)(p.ws + OFF_H);
    const bf16_t* wt = (const bf16_t*)(p.ws + OFF_WIN) + (size_t)l * INC * D;
    bf16_t* z = (bf16_t*)(p.ws + OFF_Z);
    bf16_t* vt = (bf16_t*)(p.ws + OFF_VT);
    float* out_k = p.out + (size_t)T * D;
    float* out_v = out_k + (size_t)16 * 2 * 256 * 1024;
    for (int item = blockIdx.x; item < 48 * 80; item += gridDim.x) {
        const int tn = item / 48, tm = item - tn * 48, a0 = tm * 128, n0 = tn * 128;
        f32x4 acc[4][4]; zero_acc(acc);
        gemm_tile<128, 2>(h + (size_t)a0 * D, D, wt + (size_t)n0 * D, D, D, acc, smem, TID);
#pragma unroll
        for (int j = 0; j < 4; ++j) {
            const int a = a0 + wr * 64 + j * 16 + l15;
#pragma unroll
            for (int i = 0; i < 4; ++i) {
                const int n = n0 + wc * 64 + i * 16 + 4 * g;
                const f32x4 v = acc[i][j];
                *(u32x2*)(z + (size_t)a * INC + n) = pk4(v);
                if (n0 >= 4096 && n0 < 5120) {
                    if (a < TC) { const int b = a >> 8, s = a & 255; *(f32x4*)(out_k + ((size_t)(b * 2 + l) * 256 + s) * 1024 + (n - 4096)) = v; }
                } else if (n0 >= 5120 && n0 < 6144) {
                    const int hd = n - 5120;
                    if (a < TC) {
                        const int b = a >> 8, s = a & 255;
                        *(f32x4*)(out_v + ((size_t)(b * 2 + l) * 256 + s) * 1024 + hd) = v;
                        bf16_t* vp = vt + ((size_t)b * 1024 + hd) * 256 + s;
                        const u32x2 pk = pk4(v);
                        vp[0] = (bf16_t)(pk.x & 0xffff); vp[256] = (bf16_t)(pk.x >> 16); vp[512] = (bf16_t)(pk.y & 0xffff); vp[768] = (bf16_t)(pk.y >> 16);
                    } else {
                        const int b = (a - TC) >> 10, s = (a - TC) & 1023;
                        bf16_t* vp = vt + (size_t)16 * 1024 * 256 + ((size_t)b * 1024 + hd) * 1024 + s;
                        const u32x2 pk = pk4(v);
                        vp[0] = (bf16_t)(pk.x & 0xffff); vp[1024] = (bf16_t)(pk.x >> 16); vp[2048] = (bf16_t)(pk.y & 0xffff); vp[3072] = (bf16_t)(pk.y >> 16);
                    }
                }
            }
        }
    }
}

__device__ __forceinline__ void phase_mix(const Params& p, int l, bf16_t* smem, const int TID) {
    TILE_IDS
    const bf16_t* z = (const bf16_t*)(p.ws + OFF_Z);
    const bf16_t* vt = (const bf16_t*)(p.ws + OFF_VT);
    bf16_t* att = (bf16_t*)(p.ws + OFF_ATT);
    constexpr int N_LAT = 512, N_CTX = 512, N_F1 = 768;
    for (int item = blockIdx.x; item < N_LAT + N_CTX; item += gridDim.x) {
        {
            const bool lat = item < N_LAT;
            int b, hh, qpos0, tb, hv = 0, r = 0, r0 = 0, nsub;
            const bf16_t* kbase; const bf16_t* vbase; size_t kstride, ksub; int vstride, vsub;
            if (lat) {
                hv = item >> 8; const int it2 = item & 255;
                const int grp = (it2 & 7) + 8 * (it2 >> 7);
                r = (it2 >> 3) & 15; b = grp >> 3; hh = grp & 7;
                tb = TC + b * 1024; qpos0 = r * 64 + wave * 16; nsub = 8;
                r0 = r - 4; r0 = r0 < 0 ? 0 : (r0 > 8 ? 8 : r0);
                if (hv == 0) {
                    kbase = z + (size_t)(tb + r0 * 64) * INC + 4096 + hh * 128; kstride = INC; ksub = (size_t)64 * INC;
                    vbase = vt + (size_t)16 * 1024 * 256 + ((size_t)b * 1024 + hh * 128) * 1024 + r0 * 64; vstride = 1024; vsub = 64;
                } else {
                    kbase = (const bf16_t*)(p.ws + OFF_CK) + ((size_t)(b * 2 + l) * 512) * 1024 + hh * 128; kstride = 1024; ksub = (size_t)64 * 1024;
                    vbase = (const bf16_t*)(p.ws + OFF_CVT) + ((size_t)(b * 2 + l) * 1024 + hh * 128) * 512; vstride = 512; vsub = 64;
                }
            } else {
                const int it = item - N_LAT, grp = (it & 7) + 8 * (it >> 5), qb = (it >> 3) & 3;
                b = grp >> 3; hh = grp & 7;
                tb = b * 256; qpos0 = qb * 64 + wave * 16; nsub = 4;
                kbase = z + (size_t)tb * INC + 4096 + hh * 128; kstride = INC; ksub = (size_t)64 * INC;
                vbase = vt + ((size_t)b * 1024 + hh * 128) * 256; vstride = 256; vsub = 64;
            }
            const bool loc = lat && hv == 0;
            const float* rpb_h = p.rpb + ((size_t)l * 8 + hh) * 15 * 31;
            bf16_t* Ks = smem;
            bf16_t* Vs = smem + 64 * 128;
            bf16_t* pl = smem + 2 * 64 * 128 + wave * (16 * 72);
            bf16x8 qf[4];
            {
                const bf16_t* qp = z + (size_t)(tb + qpos0 + l15) * INC + 3072 + hh * 128 + g * 8;
#pragma unroll
                for (int ks = 0; ks < 4; ++ks) qf[ks] = *(const bf16x8*)(qp + ks * 32);
            }
            float m = -3.0e38f, lsum = 0.f;
            f32x4 o[8];
#pragma unroll
            for (int dt = 0; dt < 8; ++dt) o[dt] = (f32x4){0.f, 0.f, 0.f, 0.f};
            u32x4 rk[4], rv[4];
            const int tid = TID;
#define AT_LOAD(I) do { const bf16_t* kb_ = kbase + (size_t)(I) * ksub; const bf16_t* vb_ = vbase + (size_t)(I) * vsub; \
                _Pragma("unroll") for (int e = 0; e < 4; ++e) { const int id_ = tid + 256 * e; \
                    rk[e] = *(const u32x4*)(kb_ + (size_t)(id_ >> 4) * kstride + (id_ & 15) * 8); \
                    rv[e] = *(const u32x4*)(vb_ + (size_t)(id_ >> 3) * vstride + (id_ & 7) * 8); } } while (0)
#define AT_STORE() do { _Pragma("unroll") for (int e = 0; e < 4; ++e) { const int id_ = tid + 256 * e; \
                    { const int key_ = id_ >> 4, ch_ = id_ & 15; *(u32x4*)(Ks + key_ * 128 + ((ch_ ^ (key_ & 15)) * 8)) = rk[e]; } \
                    { const int d_ = id_ >> 3, ch_ = id_ & 7; *(u32x4*)(Vs + d_ * 64 + ((ch_ ^ ((d_ >> 1) & 7)) * 8)) = rv[e]; } } } while (0)
            AT_LOAD(0);
            float* rpl = (float*)(smem + 2 * 64 * 128 + 4 * 16 * 72);
            if (loc) { for (int idx = tid; idx < 15 * 31; idx += 256) rpl[idx] = rpb_h[idx]; }
            AT_STORE();
            __syncthreads();
            const float SC2 = 0.08838834764831845f * 1.4426950408889634f;
#pragma unroll 1
            for (int i = 0; i < nsub; ++i) {
                if (i + 1 < nsub) AT_LOAD(i + 1);
                f32x4 st[4];
#pragma unroll
                for (int nt = 0; nt < 4; ++nt) {
                    f32x4 a4 = (f32x4){0.f, 0.f, 0.f, 0.f};
#pragma unroll
                    for (int ks = 0; ks < 4; ++ks) {
                        const bf16x8 kf = *(const bf16x8*)(Ks + (nt * 16 + l15) * 128 + (((ks * 4 + g) ^ l15) * 8));
                        a4 = __builtin_amdgcn_mfma_f32_16x16x32_bf16(kf, qf[ks], a4, 0, 0, 0);
                    }
                    st[nt] = a4 * SC2;
                    if (nt & 1) __builtin_amdgcn_sched_barrier(0);
                }
                if (loc) {
                    int qc = wave * 16 + l15; asm volatile("" : "+v"(qc));
                    int c0 = qc - 8; c0 = c0 < 0 ? 0 : (c0 > 48 ? 48 : c0);
                    const float* rp = rpl + (r0 + i - r + 7) * 31;
#pragma unroll
                    for (int nt = 0; nt < 4; ++nt) {
#pragma unroll
                        for (int jj = 0; jj < 4; ++jj) {
                            const int kc = nt * 16 + 4 * g + jj;
                            const bool inw = (kc >= c0) && (kc < c0 + 16);
                            int dc = kc - qc + 15; dc = dc < 0 ? 0 : (dc > 30 ? 30 : dc);
                            st[nt][jj] = inw ? (st[nt][jj] + rp[dc] * 1.4426950408889634f) : -1.0e30f;
                        }
                    }
                }
                float cmax = -3.0e38f;
#pragma unroll
                for (int nt = 0; nt < 4; ++nt) cmax = fmaxf(fmaxf(cmax, fmaxf(st[nt][0], st[nt][1])), fmaxf(st[nt][2], st[nt][3]));
                cmax = fmaxf(cmax, SHFL_XOR(cmax, 16)); cmax = fmaxf(cmax, SHFL_XOR(cmax, 32));
                const float mn = fmaxf(m, cmax), alpha = __builtin_amdgcn_exp2f(m - mn);
                m = mn;
                float ps = 0.f;
#pragma unroll
                for (int nt = 0; nt < 4; ++nt) {
                    f32x4 pv;
#pragma unroll
                    for (int jj = 0; jj < 4; ++jj) { pv[jj] = __builtin_amdgcn_exp2f(st[nt][jj] - mn); ps += pv[jj]; }
                    *(u32x2*)(pl + l15 * 72 + nt * 16 + 4 * g) = pk4(pv);
                }
                ps += SHFL_XOR(ps, 16); ps += SHFL_XOR(ps, 32);
                lsum = lsum * alpha + ps;
#pragma unroll
                for (int dt = 0; dt < 8; ++dt) o[dt] = o[dt] * alpha;
                __builtin_amdgcn_wave_barrier();
                bf16x8 pf[2];
#pragma unroll
                for (int ks = 0; ks < 2; ++ks) pf[ks] = *(const bf16x8*)(pl + l15 * 72 + ks * 32 + g * 8);
#pragma unroll
                for (int dt = 0; dt < 8; ++dt) {
#pragma unroll
                    for (int ks = 0; ks < 2; ++ks) {
                        const bf16x8 vf = *(const bf16x8*)(Vs + (dt * 16 + l15) * 64 + (((ks * 4 + g) ^ ((l15 >> 1) & 7)) * 8));
                        o[dt] = __builtin_amdgcn_mfma_f32_16x16x32_bf16(vf, pf[ks], o[dt], 0, 0, 0);
                    }
                    if ((dt & 3) == 3) __builtin_amdgcn_sched_barrier(0);
                }
                __syncthreads();
                if (i + 1 < nsub) { AT_STORE(); __syncthreads(); }
            }
#undef AT_LOAD
#undef AT_STORE
            if (lat) {
                float* pp = (float*)(p.ws + OFF_Q) + ((size_t)(((b * 8 + hh) * 1024 + qpos0 + l15) * 2 + hv)) * 132;
#pragma unroll
                for (int dt = 0; dt < 8; ++dt) *(f32x4*)(pp + dt * 16 + 4 * g) = o[dt];
                if (g == 0) { pp[128] = m; pp[129] = lsum; }
            } else {
                const float inv = 1.f / lsum;
                bf16_t* op = att + (size_t)(tb + qpos0 + l15) * D + hh * 128 + 4 * g;
#pragma unroll
                for (int dt = 0; dt < 8; ++dt) *(u32x2*)(op + dt * 16) = pk4(o[dt] * inv);
            }
            __syncthreads();
        }
    }
    for (int item = N_LAT + N_CTX + blockIdx.x; item < N_LAT + N_CTX + N_F1; item += gridDim.x) {
        {
            int it = item - (N_LAT + N_CTX);
            int S, bg, mt, nt, tb; size_t pbase;
            if (it < 512) { S = 256; bg = it >> 3; mt = (it >> 1) & 3; nt = it & 1; tb = (bg >> 2) * 256; pbase = (size_t)bg * 256 * 512; }
            else { it -= 512; S = 1024; bg = it >> 5; mt = (it >> 3) & 3; nt = it & 7; tb = TC + (bg >> 2) * 1024; pbase = (size_t)64 * 256 * 512 + (size_t)bg * 256 * 2048; }
            const int gq = bg & 3;
            f32x4 acc[4][4]; zero_acc(acc);
            gemm_tile<128>((const bf16_t*)(p.ws + OFF_D1) + (size_t)mt * 128 * 256, 256, z + (size_t)(tb + nt * 128) * INC + 6144 + gq * 256, INC, 256, acc, smem, TID);
            bf16_t* pqt = (bf16_t*)(p.ws + OFF_PQT) + pbase;
#pragma unroll
            for (int j = 0; j < 4; ++j) {
                const int a = mt * 128 + wr * 64 + j * 16 + l15, pq = a >> 8, cp = a & 255;
#pragma unroll
                for (int i = 0; i < 4; ++i) {
                    const int s = nt * 128 + wc * 64 + i * 16 + 4 * g;
                    *(u32x2*)(pqt + (size_t)cp * (2 * S) + pq * S + s) = pk4(acc[i][j]);
                }
            }
        }
    }
    {
        bf16_t* aconv = (bf16_t*)(p.ws + OFF_ACONV);
        const float* cw = p.conv_w + (size_t)l * 3 * 1024;
        for (size_t i = (size_t)blockIdx.x * 256 + TID; i < (size_t)T * 128; i += (size_t)gridDim.x * 256) {
            const int t = (int)(i >> 7), c = (int)(i & 127) * 8;
            const int s = t < TC ? (t & 255) : ((t - TC) & 1023), S = t < TC ? 256 : 1024;
            const bf16_t* zr = z + (size_t)t * INC + c;
            const u32x4 cb = *(const u32x4*)zr;
            const u32x4 c1 = *(const u32x4*)(zr + 1024), x1 = *(const u32x4*)(zr + 2048);
            u32x4 c0 = (u32x4){0, 0, 0, 0}, x0 = c0, c2 = c0, x2 = c0;
            if (s > 0) { c0 = *(const u32x4*)(zr - INC + 1024); x0 = *(const u32x4*)(zr - INC + 2048); }
            if (s + 1 < S) { c2 = *(const u32x4*)(zr + INC + 1024); x2 = *(const u32x4*)(zr + INC + 2048); }
            u32x4 o;
#pragma unroll
            for (int e = 0; e < 4; ++e) {
                const float w0a = cw[c + 2 * e], w0b = cw[c + 2 * e + 1], w1a = cw[1024 + c + 2 * e], w1b = cw[1024 + c + 2 * e + 1], w2a = cw[2048 + c + 2 * e], w2b = cw[2048 + c + 2 * e + 1];
                const float ua = w0a * bf_lo(c0[e]) * bf_lo(x0[e]) + w1a * bf_lo(c1[e]) * bf_lo(x1[e]) + w2a * bf_lo(c2[e]) * bf_lo(x2[e]);
                const float ub = w0b * bf_hi(c0[e]) * bf_hi(x0[e]) + w1b * bf_hi(c1[e]) * bf_hi(x1[e]) + w2b * bf_hi(c2[e]) * bf_hi(x2[e]);
                o[e] = pk2(bf_lo(cb[e]) * ua, bf_hi(cb[e]) * ub);
            }
            *(u32x4*)(aconv + (size_t)t * D + c) = o;
        }
    }
}

__device__ __forceinline__ void phase_f2(const Params& p, bf16_t* smem, const int TID) {
    TILE_IDS
    bf16_t* four = (bf16_t*)(p.ws + OFF_FOUR);
    {
        const float* part = (const float*)(p.ws + OFF_Q);
        bf16_t* att = (bf16_t*)(p.ws + OFF_ATT);
        for (size_t i = (size_t)blockIdx.x * 256 + TID; i < (size_t)2 * 8 * 1024 * 32; i += (size_t)gridDim.x * 256) {
            const int d4 = (int)(i & 31), bhq = (int)(i >> 5), qpos = bhq & 1023, bh = bhq >> 10, bb = bh >> 3, hh = bh & 7;
            const float* p0 = part + (size_t)bhq * 2 * 132, *p1 = p0 + 132;
            const float m0 = p0[128], l0 = p0[129], m1 = p1[128], l1 = p1[129];
            const float mm = fmaxf(m0, m1), w0 = __builtin_amdgcn_exp2f(m0 - mm), w1 = __builtin_amdgcn_exp2f(m1 - mm);
            const float inv = 1.f / (w0 * l0 + w1 * l1);
            const f32x4 a0 = *(const f32x4*)(p0 + d4 * 4), a1 = *(const f32x4*)(p1 + d4 * 4);
            *(u32x2*)(att + (size_t)(TC + bb * 1024 + qpos) * D + hh * 128 + d4 * 4) = pk4((a0 * w0 + a1 * w1) * inv);
        }
    }
    for (int item = blockIdx.x; item < 512; item += gridDim.x) {
        if (item < 256) {
            const int bg = item >> 5, mt = (item >> 1) & 15, nt = item & 1, tb = TC + (bg >> 2) * 1024, gq = bg & 3;
            const size_t pbase = (size_t)64 * 256 * 512 + (size_t)bg * 256 * 2048;
            f32x4 acc[4][2]; zero_acc(acc);
            gemm_tile<64>((const bf16_t*)(p.ws + OFF_A2L) + (size_t)mt * 64 * 2048, 2048, (const bf16_t*)(p.ws + OFF_PQT) + pbase + (size_t)nt * 128 * 2048, 2048, 2048, acc, smem, TID);
#pragma unroll
            for (int j = 0; j < 2; ++j) {
                const int a = tb + mt * 64 + wr * 32 + j * 16 + l15;
#pragma unroll
                for (int i = 0; i < 4; ++i) *(u32x2*)(four + (size_t)a * D + gq * 256 + nt * 128 + wc * 64 + i * 16 + 4 * g) = pk4(acc[i][j]);
            }
        } else {
            const int it = item - 256, bg = it >> 2, mt = (it >> 1) & 1, nt = it & 1, tb = (bg >> 2) * 256, gq = bg & 3;
            const size_t pbase = (size_t)bg * 256 * 512;
            f32x4 acc[4][4]; zero_acc(acc);
            gemm_tile<128>((const bf16_t*)(p.ws + OFF_A2C) + (size_t)mt * 128 * 512, 512, (const bf16_t*)(p.ws + OFF_PQT) + pbase + (size_t)nt * 128 * 512, 512, 512, acc, smem, TID);
#pragma unroll
            for (int j = 0; j < 4; ++j) {
                const int a = tb + mt * 128 + wr * 64 + j * 16 + l15;
#pragma unroll
                for (int i = 0; i < 4; ++i) *(u32x2*)(four + (size_t)a * D + gq * 256 + nt * 128 + wc * 64 + i * 16 + 4 * g) = pk4(acc[i][j]);
            }
        }
    }
}

__device__ __forceinline__ void phase_g3(const Params& p, int l, bf16_t* smem, const int TID) {
    TILE_IDS
    const bf16_t* z = (const bf16_t*)(p.ws + OFF_Z);
    const bf16_t* w4 = (const bf16_t*)(p.ws + OFF_W4) + (size_t)l * 4 * D * D;
    bf16_t* merged = (bf16_t*)(p.ws + OFF_MERGED);
    for (int item = blockIdx.x; item < 64 * 8; item += gridDim.x) {
        const int tn = item >> 6, tm = item & 63, a0 = tm * 96, n0 = tn * 128;
        f32x4 macc[4][3]; zero_acc(macc);
#pragma unroll 1
        for (int br = 0; br < 3; ++br) {
            const bf16_t* A = (const bf16_t*)(p.ws + OFF_ACONV + (size_t)br * SZ_TD2);
            f32x4 acc[4][3]; zero_acc(acc);
            gemm_tile<96, 1>(A + (size_t)a0 * D, D, w4 + (size_t)br * D * D + (size_t)n0 * D, D, D, acc, smem, TID);
#pragma unroll
            for (int j = 0; j < 3; ++j) {
                const int a = a0 + wr * 48 + j * 16 + l15;
#pragma unroll
                for (int i = 0; i < 4; ++i) {
                    const int n = n0 + wc * 64 + i * 16 + 4 * g;
                    const u32x2 gz = *(const u32x2*)(z + (size_t)a * INC + 7168 + br * 1024 + n);
                    const float g0 = 1.f / (1.f + __expf(-bf_lo(gz.x))), g1 = 1.f / (1.f + __expf(-bf_hi(gz.x)));
                    const float g2 = 1.f / (1.f + __expf(-bf_lo(gz.y))), g3 = 1.f / (1.f + __expf(-bf_hi(gz.y)));
                    macc[i][j][0] += g0 * acc[i][j][0]; macc[i][j][1] += g1 * acc[i][j][1]; macc[i][j][2] += g2 * acc[i][j][2]; macc[i][j][3] += g3 * acc[i][j][3];
                }
            }
        }
#pragma unroll
        for (int j = 0; j < 3; ++j) {
            const int a = a0 + wr * 48 + j * 16 + l15;
#pragma unroll
            for (int i = 0; i < 4; ++i) *(u32x2*)(merged + (size_t)a * D + n0 + wc * 64 + i * 16 + 4 * g) = pk4(macc[i][j]);
        }
    }
}

__device__ __forceinline__ void phase_g4(const Params& p, int l, bf16_t* smem, const int TID) {
    TILE_IDS
    const bf16_t* merged = (const bf16_t*)(p.ws + OFF_MERGED);
    const bf16_t* wo = (const bf16_t*)(p.ws + OFF_W4) + ((size_t)l * 4 + 3) * D * D;
    const float* modl = (const float*)(p.ws + OFF_MOD) + (size_t)l * 3 * 6144;
    float* x = (float*)(p.ws + OFF_X);
    for (int item = blockIdx.x; item < 64 * 8; item += gridDim.x) {
        const int tn = item >> 6, tm = item & 63, a0 = tm * 96, n0 = tn * 128;
        f32x4 acc[4][3]; zero_acc(acc);
        gemm_tile<96>(merged + (size_t)a0 * D, D, wo + (size_t)n0 * D, D, D, acc, smem, TID);
#pragma unroll
        for (int j = 0; j < 3; ++j) {
            const int a = a0 + wr * 48 + j * 16 + l15;
            const float* g1p = modl + (size_t)tok_set(a) * 6144 + 2 * 1024;
#pragma unroll
            for (int i = 0; i < 4; ++i) {
                const int n = n0 + wc * 64 + i * 16 + 4 * g;
                const f32x4 gt = *(const f32x4*)(g1p + n);
                f32x4* xp = (f32x4*)(x + (size_t)a * D + n);
                const f32x4 xold = (l == 0) ? *(const f32x4*)(x_in_row(p, a) + n) : *xp;
                *xp = xold + gt * acc[i][j];
            }
        }
    }
}

constexpr int SROW = 128;
__device__ __forceinline__ unsigned umax(unsigned a, unsigned b) { return a > b ? a : b; }
__device__ __forceinline__ unsigned umin(unsigned a, unsigned b) { return a > b ? b : a; }
__device__ __forceinline__ void sort16_desc(unsigned (&k)[16]) {
#pragma unroll
    for (int size = 2; size <= 16; size <<= 1) {
#pragma unroll
        for (int stride = size >> 1; stride > 0; stride >>= 1) {
#pragma unroll
            for (int i = 0; i < 16; ++i) {
                const int j = i ^ stride;
                if (j > i) {
                    const bool desc = (i & size) == 0;
                    const unsigned hi = umax(k[i], k[j]), lo = umin(k[i], k[j]);
                    k[i] = desc ? hi : lo; k[j] = desc ? lo : hi;
                }
            }
        }
    }
}
__device__ __forceinline__ void merge16(unsigned (&lst)[16], const unsigned (&nw)[16]) {
#pragma unroll
    for (int i = 0; i < 16; ++i) lst[i] = umax(lst[i], nw[15 - i]);
#pragma unroll
    for (int stride = 8; stride > 0; stride >>= 1) {
#pragma unroll
        for (int i = 0; i < 16; ++i) {
            const int j = i ^ stride;
            if (j > i) { const unsigned hi = umax(lst[i], lst[j]), lo = umin(lst[i], lst[j]); lst[i] = hi; lst[j] = lo; }
        }
    }
}
__device__ __forceinline__ void topk_half(const float* sc, unsigned* exch, unsigned (&lst)[16], const int TID) {
    const int tid = TID, row = tid >> 1, half = tid & 1;
    const float* rp = sc + row * SROW;
    const bool live = row < 96;
#pragma unroll 1
    for (int grp = 0; grp < (live ? 4 : 0); ++grp) {
        unsigned nw[16];
#pragma unroll
        for (int e4 = 0; e4 < 4; ++e4) {
            const int e = grp * 4 + e4;
            const f32x4 v = *(const f32x4*)(rp + (((2 * e + half) ^ (row & 31)) << 2));
            const unsigned n = (unsigned)(e * 8 + half * 4);
#pragma unroll
            for (int c = 0; c < 4; ++c) nw[e4 * 4 + c] = (f2key(v[c]) & 0xffffff80u) | (n + c);
        }
        sort16_desc(nw);
        if (grp == 0) {
#pragma unroll
            for (int j = 0; j < 16; ++j) lst[j] = nw[j];
        } else merge16(lst, nw);
    }
    __syncthreads();
    if (half && live) {
#pragma unroll
        for (int j = 0; j < 16; ++j) exch[row * 16 + j] = lst[j];
    }
    __syncthreads();
    if (!half && live) {
        unsigned nw[16];
#pragma unroll
        for (int j = 0; j < 16; ++j) nw[j] = exch[row * 16 + j];
        merge16(lst, nw);
    }
    __syncthreads();
}

__device__ __forceinline__ void phase_g5(const Params& p, int l, bf16_t* smem, const int TID) {
    TILE_IDS
    const bf16_t* h2 = (const bf16_t*)(p.ws + OFF_H);
    const bf16_t* wpq = (const bf16_t*)(p.ws + OFF_WPQ) + (size_t)l * 2048 * D;
    const bf16_t* sk = (const bf16_t*)(p.ws + OFF_SK) + (size_t)l * 8 * 2 * 128 * 128;
    bf16_t* q = (bf16_t*)(p.ws + OFF_Q);
    int* eidx = (int*)(p.ws + OFF_EIDX);
    float* gate = (float*)(p.ws + OFF_GATE);
    float* sc = (float*)smem;
    unsigned* exch = (unsigned*)smem;
    for (int item = blockIdx.x; item < 64 * 8; item += gridDim.x) {
        const int head = item >> 6, tm = item & 63, a0 = tm * 96;
        unsigned l0[16], l1[16];
#pragma unroll
        for (int pp = 0; pp < 2; ++pp) {
            const int c0 = (head * 2 + pp) * 128;
            {
                f32x4 acc[4][3]; zero_acc(acc);
                gemm_tile<96, 0>(h2 + (size_t)a0 * D, D, wpq + (size_t)c0 * D, D, D, acc, smem, TID);
#pragma unroll
                for (int j = 0; j < 3; ++j) {
                    const int a = wr * 48 + j * 16 + l15;
#pragma unroll
                    for (int i = 0; i < 4; ++i) {
                        const int chunk = 2 * i + (g >> 1);
                        *(u32x2*)(smem + wc * 2 * LTILE + a * LROW + ((chunk ^ ((a >> 1) & 7)) * 8) + (g & 1) * 4) = pk4(acc[i][j]);
                    }
                }
            }
            {
                f32x4 acc[4][3]; zero_acc(acc);
                gemm_tile_lds_act<96>(sk + (size_t)(head * 2 + pp) * 128 * 128, 128, acc, smem, TID);
#pragma unroll
                for (int j = 0; j < 3; ++j) {
                    const int a = wr * 48 + j * 16 + l15;
#pragma unroll
                    for (int i = 0; i < 4; ++i) *(f32x4*)(sc + a * SROW + (((wc * 16 + i * 4 + g) ^ (a & 31)) << 2)) = acc[i][j];
                }
            }
            __syncthreads();
            if (pp == 0) topk_half(sc, exch, l0, TID); else topk_half(sc, exch, l1, TID);
        }
        const int tid = TID, row = tid >> 1, half = tid & 1;
        unsigned* lsts = (unsigned*)smem;
        if (!half && row < 96) {
#pragma unroll
            for (int j = 0; j < 16; ++j) { lsts[row * 32 + j] = l0[j]; lsts[row * 32 + 16 + j] = l1[j]; }
        }
        __syncthreads();
        if (!half && row < 96) {
            float s1[16], s2[16];
#pragma unroll
            for (int j = 0; j < 16; ++j) { s1[j] = key2f(l0[j] & 0xffffff80u); s2[j] = key2f(l1[j] & 0xffffff80u); }
#define CAND(a, b) ((f2key(s1[a] + s2[b]) & 0xffffff00u) | (unsigned)((a) * 16 + (b)))
            unsigned cl[16];
#pragma unroll
            for (int b = 0; b < 16; ++b) cl[b] = CAND(0, b);
            {
                unsigned nw[16] = {CAND(1, 0), CAND(1, 1), CAND(1, 2), CAND(1, 3), CAND(1, 4), CAND(1, 5), CAND(1, 6), CAND(1, 7),
                                   CAND(2, 0), CAND(2, 1), CAND(2, 2), CAND(2, 3), CAND(2, 4), CAND(3, 0), CAND(3, 1), CAND(3, 2)};
                sort16_desc(nw); merge16(cl, nw);
            }
            {
                unsigned nw[16] = {CAND(3, 3), CAND(4, 0), CAND(4, 1), CAND(4, 2), CAND(5, 0), CAND(5, 1), CAND(6, 0), CAND(6, 1),
                                   CAND(7, 0), CAND(7, 1), CAND(8, 0), CAND(9, 0), CAND(10, 0), CAND(11, 0), CAND(12, 0), CAND(13, 0)};
                sort16_desc(nw); merge16(cl, nw);
            }
            {
                unsigned nw[16] = {CAND(14, 0), CAND(15, 0), 0u, 0u, 0u, 0u, 0u, 0u, 0u, 0u, 0u, 0u, 0u, 0u, 0u, 0u};
                merge16(cl, nw);
            }
#undef CAND
            const float mx = key2f(cl[0] & 0xffffff00u);
            float ev[16], es = 0.f;
#pragma unroll
            for (int j = 0; j < 16; ++j) { ev[j] = __expf(key2f(cl[j] & 0xffffff00u) - mx); es += ev[j]; }
            const float inv = 1.f / es;
            const size_t ob = (size_t)(a0 + row) * 128 + head * 16;
#pragma unroll
            for (int j = 0; j < 16; ++j) {
                const unsigned ab = cl[j] & 0xffu;
                const unsigned i1 = lsts[row * 32 + (ab >> 4)] & 127u, i2 = lsts[row * 32 + 16 + (ab & 15u)] & 127u;
                eidx[ob + j] = (int)(i1 * 128u + i2);
                gate[ob + j] = ev[j] * inv;
            }
        }
        __syncthreads();
    }
}

__device__ __forceinline__ void peer_load(const unsigned char* __restrict__ tab, int e0, int e1, int gi, int lane, u32x4 (&w)[8]) {
    const int ecur = gi < 8 ? e0 : e1, sbase = (gi & 7) * 8;
#pragma unroll
    for (int k = 0; k < 8; ++k) w[k] = *(const u32x4*)(tab + (size_t)__builtin_amdgcn_readlane(ecur, sbase + k) * D + lane * 16);
}
__device__ __forceinline__ float gelu_bf(float v) {
    const float av = __builtin_fabsf(v), t = __builtin_amdgcn_rcpf(av * 0.2316418882f + 1.0f);
    float q = t * 0.5307027145f + (-0.7265760135f); q = q * t + 0.7107068705f; q = q * t + (-0.142248368f); q = q * t + 0.127414796f; q = q * t;
    const float e = __builtin_amdgcn_exp2f((v * v) * (-0.72134752044f));
    const float m = v * (q * e), r = v - m;
    return v < 0.f ? m : r;
}
__device__ __forceinline__ float peer_dots(const u32x4 (&uw)[8], const f32x2v (&hf2)[8], float g0, float g1, int gi, int lane, int kperm) {
    float pd[8];
#pragma unroll
    for (int k = 0; k < 8; ++k) {
        f32x2v s2 = (f32x2v){0.f, 0.f};
#pragma unroll
        for (int d = 0; d < 4; ++d) {
            const f32x2v lo = __builtin_amdgcn_cvt_pk_f32_fp8((int)uw[k][d], false), hi = __builtin_amdgcn_cvt_pk_f32_fp8((int)uw[k][d], true);
            s2 += lo * hf2[2 * d]; s2 += hi * hf2[2 * d + 1];
        }
        pd[k] = s2.x + s2.y;
    }
    float q4[4], r2[2], s1;
    {
        const bool b0 = lane & 1;
#pragma unroll
        for (int i = 0; i < 4; ++i) { const float snd = b0 ? pd[i] : pd[4 + i]; const float rcv = SHFL_XOR(snd, 1); q4[i] = (b0 ? pd[4 + i] : pd[i]) + rcv; }
        const bool b1 = lane & 2;
#pragma unroll
        for (int i = 0; i < 2; ++i) { const float snd = b1 ? q4[i] : q4[2 + i]; const float rcv = SHFL_XOR(snd, 2); r2[i] = (b1 ? q4[2 + i] : q4[i]) + rcv; }
        const bool b2 = lane & 4;
        { const float snd = b2 ? r2[0] : r2[1]; const float rcv = SHFL_XOR(snd, 4); s1 = (b2 ? r2[1] : r2[0]) + rcv; }
        s1 += SHFL_XOR(s1, 8); s1 += SHFL_XOR(s1, 16); s1 += SHFL_XOR(s1, 32);
    }
    s1 *= (1.f / 64.f);
    const float gk = shfl_idx(gi < 8 ? g0 : g1, (gi & 7) * 8 + kperm);
    return gelu_bf(s1) * gk * (1.f / 16.f);
}
__device__ __forceinline__ void peer_accum(const u32x4 (&vw)[8], const float* cfg, f32x2v (&acc2)[8]) {
#pragma unroll
    for (int k = 0; k < 8; ++k) {
        const int src = ((k & 1) << 2) | (k & 2) | ((k >> 2) & 1);
        const float ck = cfg[src];
        const f32x2v ck2 = (f32x2v){ck, ck};
#pragma unroll
        for (int d = 0; d < 4; ++d) {
            const f32x2v lo = __builtin_amdgcn_cvt_pk_f32_fp8((int)vw[k][d], false), hi = __builtin_amdgcn_cvt_pk_f32_fp8((int)vw[k][d], true);
            acc2[2 * d] += ck2 * lo; acc2[2 * d + 1] += ck2 * hi;
        }
    }
}
__device__ __forceinline__ void sort128(unsigned& a0, unsigned& a1, int lane) {
#pragma unroll
    for (int size = 2; size <= 128; size <<= 1) {
#pragma unroll
        for (int stride = size >> 1; stride > 0; stride >>= 1) {
            if (stride == 64) {
                const unsigned lo = a0 < a1 ? a0 : a1, hi = a0 < a1 ? a1 : a0; a0 = lo; a1 = hi;
            } else {
                unsigned p0, p1;
                if (stride == 1) { p0 = (unsigned)dpp_xor1((int)a0); p1 = (unsigned)dpp_xor1((int)a1); }
                else if (stride == 2) { p0 = (unsigned)dpp_xor2((int)a0); p1 = (unsigned)dpp_xor2((int)a1); }
                else if (stride == 8) { p0 = (unsigned)dpp_xor8((int)a0); p1 = (unsigned)dpp_xor8((int)a1); }
                else { p0 = (unsigned)__builtin_amdgcn_ds_bpermute((lane ^ stride) << 2, (int)a0); p1 = (unsigned)__builtin_amdgcn_ds_bpermute((lane ^ stride) << 2, (int)a1); }
                const bool lower = (lane & stride) == 0;
                const bool up0 = (size >= 128) ? true : ((lane & size) == 0);
                const bool up1 = (size >= 128) ? true : (size == 64 ? false : ((lane & size) == 0));
                const unsigned mn0 = a0 < p0 ? a0 : p0, mx0 = a0 < p0 ? p0 : a0, mn1 = a1 < p1 ? a1 : p1, mx1 = a1 < p1 ? p1 : a1;
                a0 = (lower == up0) ? mn0 : mx0;
                a1 = (lower == up1) ? mn1 : mx1;
            }
        }
    }
}
__device__ __forceinline__ void phase_peer(const Params& p, int l, float* smemf, const int TID) {
    const int lane = TID & 63, wave = TID >> 6;
    const bf16_t* h2 = (const bf16_t*)(p.ws + OFF_H);
    const unsigned char* pu = p.ws + OFF_PU + (size_t)l * 16384 * D;
    const unsigned char* pv = p.ws + OFF_PV + (size_t)l * 16384 * D;
    const int* eidx = (const int*)(p.ws + OFF_EIDX);
    const float* gate = (const float*)(p.ws + OFF_GATE);
    float* x = (float*)(p.ws + OFF_X);
    bf16_t* hout = (bf16_t*)(p.ws + OFF_H);
    const float* modl = (const float*)(p.ws + OFF_MOD) + (size_t)l * 3 * 6144;
    const int kperm = ((lane & 1) << 2) | (lane & 2) | ((lane >> 2) & 1);
    const int nslot = (T + (int)gridDim.x * 4 - 1) / ((int)gridDim.x * 4);
    float* cfl = smemf + wave * (nslot * 128);
    int* esl = (int*)(smemf + 4 * nslot * 128) + wave * (nslot * 128);
    int slot = 0;
    for (int tok = blockIdx.x * 4 + wave; tok < T; tok += gridDim.x * 4, ++slot) {
        unsigned k0 = ((unsigned)eidx[(size_t)tok * 128 + lane] << 7) | (unsigned)lane, k1 = ((unsigned)eidx[(size_t)tok * 128 + 64 + lane] << 7) | (unsigned)(64 + lane);
        sort128(k0, k1, lane);
        const int e0 = (int)(k0 >> 7), e1 = (int)(k1 >> 7);
        const float g0 = gate[(size_t)tok * 128 + (k0 & 127u)], g1 = gate[(size_t)tok * 128 + (k1 & 127u)];
        esl[slot * 128 + lane] = e0; esl[slot * 128 + 64 + lane] = e1;
        u32x4 ua[8], ub[8];
        peer_load(pu, e0, e1, 0, lane, ua);
        const u32x4 ha = *(const u32x4*)(h2 + (size_t)tok * D + lane * 16), hb = *(const u32x4*)(h2 + (size_t)tok * D + lane * 16 + 8);
        f32x2v hf2[8];
#pragma unroll
        for (int e = 0; e < 4; ++e) { hf2[e] = (f32x2v){bf_lo(ha[e]), bf_hi(ha[e])}; hf2[4 + e] = (f32x2v){bf_lo(hb[e]), bf_hi(hb[e])}; }
#pragma unroll 1
        for (int g2 = 0; g2 < 8; ++g2) {
            peer_load(pu, e0, e1, 2 * g2 + 1, lane, ub);
            const float c0 = peer_dots(ua, hf2, g0, g1, 2 * g2, lane, kperm);
            if (lane < 8) cfl[(slot * 16 + 2 * g2) * 8 + lane] = c0;
            if (g2 < 7) peer_load(pu, e0, e1, 2 * g2 + 2, lane, ua);
            const float c1 = peer_dots(ub, hf2, g0, g1, 2 * g2 + 1, lane, kperm);
            if (lane < 8) cfl[(slot * 16 + 2 * g2 + 1) * 8 + lane] = c1;
        }
    }
    __builtin_amdgcn_wave_barrier();
    slot = 0;
    for (int tok = blockIdx.x * 4 + wave; tok < T; tok += gridDim.x * 4, ++slot) {
        const int e0 = esl[slot * 128 + lane], e1 = esl[slot * 128 + 64 + lane];
        u32x4 va[8], vb[8];
        peer_load(pv, e0, e1, 0, lane, va);
        f32x2v acc2[8];
#pragma unroll
        for (int e = 0; e < 8; ++e) acc2[e] = (f32x2v){0.f, 0.f};
#pragma unroll 1
        for (int g2 = 0; g2 < 8; ++g2) {
            peer_load(pv, e0, e1, 2 * g2 + 1, lane, vb);
            peer_accum(va, cfl + (slot * 16 + 2 * g2) * 8, acc2);
            if (g2 < 7) peer_load(pv, e0, e1, 2 * g2 + 2, lane, va);
            peer_accum(vb, cfl + (slot * 16 + 2 * g2 + 1) * 8, acc2);
        }
        float acc[16];
#pragma unroll
        for (int e = 0; e < 8; ++e) { acc[2 * e] = acc2[e].x; acc[2 * e + 1] = acc2[e].y; }
        const int set = tok_set(tok);
        const float* g2p = modl + (size_t)set * 6144 + 5 * 1024;
        float xn[16]; float ss = 0.f;
#pragma unroll
        for (int q4i = 0; q4i < 4; ++q4i) {
            const int n = lane * 16 + q4i * 4, e = q4i * 4;
            const float4 xv = *(const float4*)(x + (size_t)tok * D + n), gv = *(const float4*)(g2p + n);
            xn[e] = xv.x + gv.x * acc[e]; xn[e + 1] = xv.y + gv.y * acc[e + 1]; xn[e + 2] = xv.z + gv.z * acc[e + 2]; xn[e + 3] = xv.w + gv.w * acc[e + 3];
            ss += xn[e] * xn[e] + xn[e + 1] * xn[e + 1] + xn[e + 2] * xn[e + 2] + xn[e + 3] * xn[e + 3];
        }
        ss = wave_sum(ss, lane);
        const float rstd = rsqrtf(ss * (1.f / D) + RMS_EPS);
        const int n0 = lane * 16;
        if (l == 0) {
            const float* gw = p.g_mix + 1024;
            const float* m1 = (const float*)(p.ws + OFF_MOD) + (size_t)(3 + set) * 6144;
            float y[16];
#pragma unroll
            for (int q4i = 0; q4i < 4; ++q4i) {
                const int e = q4i * 4;
                *(float4*)(x + (size_t)tok * D + n0 + e) = make_float4(xn[e], xn[e + 1], xn[e + 2], xn[e + 3]);
                const float4 gg = *(const float4*)(gw + n0 + e), sc = *(const float4*)(m1 + 1024 + n0 + e), sh = *(const float4*)(m1 + n0 + e);
                y[e] = xn[e] * rstd * gg.x * (1.f + sc.x) + sh.x; y[e + 1] = xn[e + 1] * rstd * gg.y * (1.f + sc.y) + sh.y;
                y[e + 2] = xn[e + 2] * rstd * gg.z * (1.f + sc.z) + sh.z; y[e + 3] = xn[e + 3] * rstd * gg.w * (1.f + sc.w) + sh.w;
            }
            u32x4 o0, o1;
            o0.x = pk2(y[0], y[1]); o0.y = pk2(y[2], y[3]); o0.z = pk2(y[4], y[5]); o0.w = pk2(y[6], y[7]);
            o1.x = pk2(y[8], y[9]); o1.y = pk2(y[10], y[11]); o1.z = pk2(y[12], y[13]); o1.w = pk2(y[14], y[15]);
            *(u32x4*)(hout + (size_t)tok * D + n0) = o0; *(u32x4*)(hout + (size_t)tok * D + n0 + 8) = o1;
        } else {
#pragma unroll
            for (int q4i = 0; q4i < 4; ++q4i) {
                const int e = q4i * 4;
                const float4 ga = *(const float4*)(p.g_final + n0 + e);
                *(float4*)(p.out + (size_t)tok * D + n0 + e) = make_float4(xn[e] * rstd * ga.x, xn[e + 1] * rstd * ga.y, xn[e + 2] * rstd * ga.z, xn[e + 3] * rstd * ga.w);
            }
        }
    }
}

__device__ __forceinline__ void run_phase(const Params& p, int ph, unsigned char* smem, const int TID) {
    bf16_t* sm = (bf16_t*)smem;
    if (ph == 0) { phase_setup(p, smem, TID); return; }
    if (ph == 1) { phase_norm(p, p.g_mix, (const float*)(p.ws + OFF_MOD), 0, 1, TID, true); return; }
    const int l = (ph - 2) >> 3, sub = (ph - 2) & 7;
    switch (sub) {
        case 0: phase_g1(p, l, sm, TID); break;
        case 1: phase_mix(p, l, sm, TID); break;
        case 2: phase_f2(p, sm, TID); break;
        case 3: phase_g3(p, l, sm, TID); break;
        case 4: phase_g4(p, l, sm, TID); break;
        case 5: phase_norm(p, p.g_ffn + (size_t)l * 1024, (const float*)(p.ws + OFF_MOD) + (size_t)l * 3 * 6144, 3, 4, TID); break;
        case 6: phase_g5(p, l, sm, TID); break;
        default: phase_peer(p, l, (float*)smem, TID); break;
    }
}

#define XB_TMO      128
#define XB_XCNT(j)  (256  + 64 * (j))
#define XB_XSUB(j)  (1280 + 64 * (j))
#define XB_XGEN(j)  (2304 + 64 * (j))
#define XB_TOP      3328
#define XB_TOPGEN   3392
#define XB_SPIN_CAP (1u << 21)
#define LAS __attribute__((address_space(3)))
__device__ __forceinline__ unsigned xb_ld(unsigned* p)              { return __hip_atomic_load(p, __ATOMIC_RELAXED, __HIP_MEMORY_SCOPE_AGENT); }
__device__ __forceinline__ unsigned xb_add(unsigned* p, unsigned v) { return __hip_atomic_fetch_add(p, v, __ATOMIC_RELAXED, __HIP_MEMORY_SCOPE_AGENT); }
__device__ __forceinline__ unsigned xb_xcc_id() { return (unsigned)__builtin_amdgcn_s_getreg((3 << 11) | 20) & 0xFu; }
#define XB_SPIN(cond, bar) do { unsigned _sp = 0; while (cond) { __builtin_amdgcn_s_sleep(1); \
    if ((++_sp & 255u) == 0u) { if (xb_ld(&(bar)[XB_TMO])) break; if (_sp > XB_SPIN_CAP) { atomicAdd(&(bar)[XB_TMO], 1u); break; } } } } while (0)
struct XcdBarrier { unsigned* bar; unsigned x; volatile LAS unsigned* st; };
__device__ __forceinline__ XcdBarrier xcd_barrier_post(unsigned* bar, volatile LAS unsigned* st) {
    XcdBarrier b; b.bar = bar; b.x = xb_xcc_id(); b.st = st;
    if (threadIdx.x == 0) (void)xb_add(&bar[XB_XCNT(b.x)], 1u);
    return b;
}
__device__ __forceinline__ void xcd_barrier_complete(unsigned* bar, unsigned x, unsigned& nloc, unsigned& nx) {
    const unsigned G = gridDim.x * gridDim.y * gridDim.z;
    unsigned sum, cnt, mine, sp = 0u;
    for (;;) {
        sum = 0u; cnt = 0u; mine = 0u;
#pragma unroll
        for (unsigned j = 0; j < 16; ++j) { const unsigned c = xb_ld(&bar[XB_XCNT(j)]); sum += c; cnt += (c > 0u) ? 1u : 0u; mine = (j == x) ? c : mine; }
        if (sum == G) break;
        __builtin_amdgcn_s_sleep(1);
        if ((++sp & 255u) == 0u) { if (xb_ld(&bar[XB_TMO])) break; if (sp > XB_SPIN_CAP) { atomicAdd(&bar[XB_TMO], 1u); break; } }
    }
    nloc = mine > 0u ? mine : 1u; nx = cnt > 0u ? cnt : 1u;
}
__device__ __forceinline__ void xcd_barrier(const XcdBarrier& b, const int tid) {
    asm volatile("s_waitcnt vmcnt(0)" ::: "memory");
    __syncthreads();
    if (tid == 0) {
        unsigned* bar = b.bar; unsigned bx = b.x; asm volatile("" : "+s"(bx));
        __builtin_amdgcn_s_waitcnt(0);
        unsigned nloc = b.st[0], nx = b.st[1];
        if (nloc == 0u) { xcd_barrier_complete(bar, bx, nloc, nx); b.st[0] = nloc; b.st[1] = nx; }
        const unsigned old = xb_add(&bar[XB_XSUB(bx)], 1u);
        const unsigned gen = old / nloc;
        if (old + 1u == (gen + 1u) * nloc) {
            __builtin_amdgcn_fence(__ATOMIC_RELEASE, "agent");
            asm volatile("s_waitcnt vmcnt(0)" ::: "memory");
            const unsigned og = xb_add(&bar[XB_TOP], 1u);
            const unsigned tg = og / nx;
            if (og + 1u == (tg + 1u) * nx) xb_add(&bar[XB_TOPGEN], 1u);
            else XB_SPIN(xb_ld(&bar[XB_TOPGEN]) == tg, bar);
            __builtin_amdgcn_fence(__ATOMIC_ACQUIRE, "agent");
            xb_add(&bar[XB_XGEN(bx)], 1u);
            asm volatile("s_waitcnt vmcnt(0)" ::: "memory");
        } else {
            XB_SPIN(xb_ld(&bar[XB_XGEN(bx)]) == gen, bar);
            __builtin_amdgcn_fence(__ATOMIC_ACQUIRE, "agent");
            asm volatile("s_waitcnt vmcnt(0)" ::: "memory");
        }
    }
    __syncthreads();
}

template <bool COOP>
__global__ void __launch_bounds__(256, 2) mega(Params p, int ph_lo, int ph_hi) {
    __shared__ __attribute__((aligned(16))) unsigned char smem[SMEM_BYTES];
    __shared__ uint4 xb_words;
    const int wave_s = __builtin_amdgcn_readfirstlane((int)threadIdx.x >> 6);
    XcdBarrier xb{};
    if (COOP) {
        if (threadIdx.x == 0) xb_words = make_uint4(0u, 0u, 0u, 0u);
        __syncthreads();
        xb = xcd_barrier_post((unsigned*)(p.ws + OFF_BAR), (volatile LAS unsigned*)&xb_words);
        if (ph_hi < 0) cg::this_grid().sync();
    }
    for (int ph = ph_lo; ph < ph_hi; ++ph) {
        unsigned zz = 0u; asm volatile("" : "+v"(zz));
        int tid = wave_s * 64 + (int)__builtin_amdgcn_mbcnt_hi(~0u, __builtin_amdgcn_mbcnt_lo(~0u, zz)); asm volatile("" : "+v"(tid));
        Params q = p; asm volatile("" : "+s"(q.ws));
        run_phase(q, ph, smem, tid);
        if (COOP) { if (ph + 1 < ph_hi) xcd_barrier(xb, tid); }
    }
}

extern "C" void kernel_launch(void* const* d_in, const int* in_sizes, int n_in, void* d_out, int out_size, void* d_ws, size_t ws_size, hipStream_t stream) {
    static int grid = 0;
#if MK_COOP
    const void* fn = (const void*)mega<true>;
#else
    const void* fn = (const void*)mega<false>;
#endif
    if (grid == 0) {
        if (n_in != 22 || ws_size < WS_END) { fprintf(stderr, "kernel_launch: need 22 inputs and >= %zu bytes of workspace (got %d, %zu)\n", (size_t)WS_END, n_in, ws_size); grid = -1; return; }
        int dev = 0, cus = 0, per_cu = 0;
        (void)hipGetDevice(&dev);
        (void)hipDeviceGetAttribute(&cus, hipDeviceAttributeMultiprocessorCount, dev);
        if (hipOccupancyMaxActiveBlocksPerMultiprocessor(&per_cu, fn, 256, 0) != hipSuccess || per_cu < 1) { fprintf(stderr, "kernel_launch: occupancy query failed (%d)\n", per_cu); (void)hipGetLastError(); per_cu = 1; }
        if (per_cu > 2) per_cu = 2;
        grid = cus * per_cu;
        fprintf(stderr, "kernel_launch: grid %d (%d CUs x %d), coop %d\n", grid, cus, per_cu, (int)MK_COOP);
    }
    if (grid < 0) return;
    Params p{};
    p.x_prompt = (const float*)d_in[0]; p.x_sample = (const float*)d_in[1]; p.cache_k = (const float*)d_in[2]; p.cache_v = (const float*)d_in[3];
    p.c = (const float*)d_in[4]; p.c_ctx = (const float*)d_in[5]; p.w_in = (const float*)d_in[6]; p.conv_w = (const float*)d_in[7];
    p.w_conv_out = (const float*)d_in[8]; p.rpb = (const float*)d_in[9]; p.w_attn_out = (const float*)d_in[10]; p.w_four_out = (const float*)d_in[11];
    p.w_o = (const float*)d_in[12]; p.g_mix = (const float*)d_in[13]; p.g_ffn = (const float*)d_in[14]; p.w_mod = (const float*)d_in[15];
    p.b_mod = (const float*)d_in[16]; p.w_pq = (const float*)d_in[17]; p.sub_keys = (const float*)d_in[18]; p.peer_u = (const float*)d_in[19];
    p.peer_v = (const float*)d_in[20]; p.g_final = (const float*)d_in[21];
    p.out = (float*)d_out; p.ws = (unsigned char*)d_ws;
#if MK_COOP
    int lo = 0, hi = NPH;
    void* args[] = {&p, &lo, &hi};
    (void)hipMemsetAsync((unsigned char*)d_ws + OFF_BAR, 0, BAR_BYTES, stream);
    hipError_t e = hipLaunchCooperativeKernel(fn, dim3(grid), dim3(256), args, 0, stream);
    if (e != hipSuccess) fprintf(stderr, "cooperative launch failed: %s (grid %d)\n", hipGetErrorString(e), grid);
#else
    for (int ph = 0; ph < NPH; ++ph) {
        hipLaunchKernelGGL(mega<false>, dim3(grid), dim3(256), 0, stream, p, ph, ph + 1);
    }
#endif
}
```

```cpp
#include <hip/hip_runtime.h>
#include <hip/hip_cooperative_groups.h>
#include <cstdio>
#include <cstdint>
namespace cg = cooperative_groups;

#ifndef MK_COOP
#define MK_COOP 1
#endif

typedef unsigned short bf16_t;
typedef short bf16x8 __attribute__((ext_vector_type(8)));
typedef float f32x4 __attribute__((ext_vector_type(4)));
typedef unsigned u32x4 __attribute__((ext_vector_type(4)));
typedef unsigned u32x2 __attribute__((ext_vector_type(2)));

constexpr int T = 6144, TC = 4096, D = 1024, INC = 10240;
constexpr int NPH = 18;
constexpr float RMS_EPS = 1e-6f;

constexpr size_t SZ_TD2 = (size_t)T * D * 2;
constexpr size_t OFF_WIN = 0;
constexpr size_t OFF_W4 = OFF_WIN + 2ull * INC * D * 2;
constexpr size_t OFF_WPQ = OFF_W4 + 2ull * 4 * D * D * 2;
constexpr size_t OFF_SK = OFF_WPQ + 2ull * 2048 * D * 2;
constexpr size_t OFF_PU = OFF_SK + 2ull * 8 * 2 * 128 * 128 * 2;
constexpr size_t OFF_PV = OFF_PU + 2ull * 16384 * D * 2;
constexpr size_t OFF_MOD = OFF_PV + 2ull * 16384 * D * 2;
constexpr size_t OFF_D1 = OFF_MOD + 2 * 3 * 6 * 1024 * 4;
constexpr size_t OFF_A2C = OFF_D1 + 512 * 256 * 2;
constexpr size_t OFF_A2L = OFF_A2C + 256 * 512 * 2;
constexpr size_t OFF_CK = OFF_A2L + 1024 * 2048 * 2;
constexpr size_t OFF_CVT = OFF_CK + 2 * 2 * 512 * 1024 * 2;
constexpr size_t OFF_X = OFF_CVT + 2 * 2 * 512 * 1024 * 2;
constexpr size_t OFF_H = OFF_X + (size_t)T * D * 4;
constexpr size_t OFF_Z = OFF_H + SZ_TD2;
constexpr size_t OFF_VT = OFF_Z + (size_t)T * INC * 2;
constexpr size_t OFF_ACONV = OFF_VT + SZ_TD2;
constexpr size_t OFF_ATT = OFF_ACONV + SZ_TD2;
constexpr size_t OFF_FOUR = OFF_ATT + SZ_TD2;
constexpr size_t OFF_PQT = OFF_FOUR + SZ_TD2;
constexpr size_t OFF_MERGED = OFF_PQT + 2 * SZ_TD2;
constexpr size_t OFF_Q = OFF_MERGED + SZ_TD2;
constexpr size_t OFF_EIDX = OFF_Q + 2 * SZ_TD2;
constexpr size_t OFF_GATE = OFF_EIDX + (size_t)T * 128 * 4;
constexpr size_t OFF_BAR = OFF_GATE + (size_t)T * 128 * 4;
constexpr size_t BAR_BYTES = 16384;
constexpr size_t WS_END = OFF_BAR + BAR_BYTES;

struct Params {
    const float *x_prompt, *x_sample, *cache_k, *cache_v, *c, *c_ctx, *w_in, *conv_w, *w_conv_out, *rpb, *w_attn_out, *w_four_out, *w_o,
        *g_mix, *g_ffn, *w_mod, *b_mod, *w_pq, *sub_keys, *peer_u, *peer_v, *g_final;
    float* out;
    unsigned char* ws;
};

typedef __bf16 bf16x2_t __attribute__((ext_vector_type(2)));
typedef float f32x2_t __attribute__((ext_vector_type(2)));
__device__ __forceinline__ unsigned pk2(float lo, float hi) { const bf16x2_t r = __builtin_convertvector((f32x2_t){lo, hi}, bf16x2_t); return __builtin_bit_cast(unsigned, r); }
__device__ __forceinline__ u32x2 pk4(f32x4 v) { u32x2 r; r.x = pk2(v[0], v[1]); r.y = pk2(v[2], v[3]); return r; }
__device__ __forceinline__ float bf_lo(unsigned w) { return __uint_as_float(w << 16); }
__device__ __forceinline__ float bf_hi(unsigned w) { return __uint_as_float(w & 0xffff0000u); }
__device__ __forceinline__ float shfl_idx(float v, int src_lane) { return __int_as_float(__builtin_amdgcn_ds_bpermute(src_lane << 2, __float_as_int(v))); }
__device__ __forceinline__ int dpp_xor1(int v) { return __builtin_amdgcn_update_dpp(v, v, 0xB1, 0xF, 0xF, true); }
__device__ __forceinline__ int dpp_xor2(int v) { return __builtin_amdgcn_update_dpp(v, v, 0x4E, 0xF, 0xF, true); }
__device__ __forceinline__ int dpp_xor8(int v) { return __builtin_amdgcn_update_dpp(v, v, 0x128, 0xF, 0xF, true); }
__device__ __forceinline__ int dpp_xor4(int v, int lane) { const int up = __builtin_amdgcn_update_dpp(v, v, 0x104, 0xF, 0xF, true), dn = __builtin_amdgcn_update_dpp(v, v, 0x114, 0xF, 0xF, true); return (lane & 4) ? dn : up; }
template <int M> __device__ __forceinline__ float shfl_xor_c(float v, int lane) {
    if (M == 4) return __int_as_float(dpp_xor4(__float_as_int(v), lane));
    if (M == 8) return __int_as_float(dpp_xor8(__float_as_int(v)));
    if (M == 1) return __int_as_float(dpp_xor1(__float_as_int(v)));
    if (M == 2) return __int_as_float(dpp_xor2(__float_as_int(v)));
    return shfl_idx(v, lane ^ M);
}
#define SHFL_XOR(v, m) shfl_xor_c<(m)>((v), lane)
__device__ __forceinline__ float wave_sum(float v, int lane) {
    v += SHFL_XOR(v, 32); v += SHFL_XOR(v, 16); v += SHFL_XOR(v, 8); v += SHFL_XOR(v, 4); v += SHFL_XOR(v, 2); v += SHFL_XOR(v, 1);
    return v;
}
__device__ __forceinline__ int tok_set(int t) { return t < TC ? 0 : 1 + ((t - TC) >> 10); }
__device__ __forceinline__ unsigned f2key(float f) { unsigned u = __float_as_uint(f); return (u & 0x80000000u) ? ~u : (u | 0x80000000u); }
__device__ __forceinline__ float key2f(unsigned k) { unsigned u = (k & 0x80000000u) ? (k & 0x7fffffffu) : ~k; return __uint_as_float(u); }

constexpr int LROW = 64;
constexpr int LTILE = 128 * LROW;
constexpr int SMEM_BYTES = 4 * LTILE * 2;

template <int MR, int DEEP = 1>
__device__ __forceinline__ void gemm_tile(const bf16_t* __restrict__ Act, int lda, const bf16_t* __restrict__ W, int ldw, int K,
                                          f32x4 (&acc)[4][MR / 32], bf16_t* smem, const int TID) {
    constexpr int JT = MR / 32, AI = MR / 32;
    const int tid = TID, lane = tid & 63, wave = tid >> 6, wr = wave >> 1, wc = wave & 1, l15 = lane & 15, g = lane >> 4;
    const int lrow = tid >> 3, lkc = (tid & 7) * 8;
    const int skc = ((tid & 7) ^ ((lrow >> 1) & 7)) * 8;
    const int rsw = (l15 >> 1) & 7;
    const bf16_t* ap = Act + (size_t)lrow * lda + lkc;
    const bf16_t* wp = W + (size_t)lrow * ldw + lkc;
    const int nk = K >> 6;
#define GT_LOAD(RA, RW, KT) do { const int k0_ = (KT) << 6; \
        _Pragma("unroll") for (int i = 0; i < AI; ++i) RA[i] = *(const u32x4*)(ap + (size_t)(32 * i) * lda + k0_); \
        _Pragma("unroll") for (int i = 0; i < 4; ++i) RW[i] = *(const u32x4*)(wp + (size_t)(32 * i) * ldw + k0_); } while (0)
#define GT_STORE(RA, RW, BUF) do { bf16_t* da_ = smem + (BUF) * 2 * LTILE; bf16_t* dw_ = da_ + LTILE; \
        _Pragma("unroll") for (int i = 0; i < AI; ++i) *(u32x4*)(da_ + (lrow + 32 * i) * LROW + skc) = RA[i]; \
        _Pragma("unroll") for (int i = 0; i < 4; ++i) *(u32x4*)(dw_ + (lrow + 32 * i) * LROW + skc) = RW[i]; } while (0)
#define GT_COMPUTE(BUF) do { const bf16_t* sa_ = smem + (BUF) * 2 * LTILE; const bf16_t* sw_ = sa_ + LTILE; \
        _Pragma("unroll") for (int ks = 0; ks < 2; ++ks) { bf16x8 af[JT], wf[4]; \
            _Pragma("unroll") for (int j = 0; j < JT; ++j) af[j] = *(const bf16x8*)(sa_ + (wr * (MR / 2) + j * 16 + l15) * LROW + ((ks * 4 + g) ^ rsw) * 8); \
            _Pragma("unroll") for (int i = 0; i < 4; ++i) wf[i] = *(const bf16x8*)(sw_ + (wc * 64 + i * 16 + l15) * LROW + ((ks * 4 + g) ^ rsw) * 8); \
            __builtin_amdgcn_s_setprio(1); \
            _Pragma("unroll") for (int i = 0; i < 4; ++i) _Pragma("unroll") for (int j = 0; j < JT; ++j) acc[i][j] = __builtin_amdgcn_mfma_f32_16x16x32_bf16(wf[i], af[j], acc[i][j], 0, 0, 0); \
            __builtin_amdgcn_s_setprio(0); } } while (0)
    u32x4 ra[AI], rw[4];
    GT_LOAD(ra, rw, 0);
    GT_STORE(ra, rw, 0);
    __syncthreads();
    if (DEEP == 2) {
        u32x4 rb[AI], rv[4], rc[AI], rx[4];
        GT_LOAD(rb, rv, 1);
        if (2 < nk) GT_LOAD(rc, rx, 2);
        for (int kt = 0; kt < nk; kt += 3) {
            if (kt + 3 < nk) GT_LOAD(ra, rw, kt + 3);
            GT_COMPUTE(kt & 1);
            if (kt + 1 < nk) GT_STORE(rb, rv, (kt + 1) & 1);
            __syncthreads();
            if (kt + 1 < nk) {
                if (kt + 4 < nk) GT_LOAD(rb, rv, kt + 4);
                GT_COMPUTE((kt + 1) & 1);
                if (kt + 2 < nk) GT_STORE(rc, rx, kt & 1);
                __syncthreads();
            }
            if (kt + 2 < nk) {
                if (kt + 5 < nk) GT_LOAD(rc, rx, kt + 5);
                GT_COMPUTE(kt & 1);
                if (kt + 3 < nk) GT_STORE(ra, rw, (kt + 1) & 1);
                __syncthreads();
            }
        }
    } else if (DEEP == 1) {
        u32x4 rb[AI], rv[4];
        GT_LOAD(ra, rw, 1);
        for (int kt = 0; kt < nk; kt += 2) {
            if (kt + 2 < nk) GT_LOAD(rb, rv, kt + 2);
            GT_COMPUTE(0);
            GT_STORE(ra, rw, 1);
            __syncthreads();
            if (kt + 3 < nk) GT_LOAD(ra, rw, kt + 3);
            GT_COMPUTE(1);
            if (kt + 2 < nk) GT_STORE(rb, rv, 0);
            __syncthreads();
        }
    } else {
        for (int kt = 0; kt < nk; ++kt) {
            const bool more = (kt + 1) < nk;
            if (more) GT_LOAD(ra, rw, kt + 1);
            GT_COMPUTE(kt & 1);
            if (more) GT_STORE(ra, rw, (kt + 1) & 1);
            __syncthreads();
        }
    }
#undef GT_LOAD
#undef GT_STORE
#undef GT_COMPUTE
}
template <int MR>
__device__ __forceinline__ void gemm_tile_lds_act(const bf16_t* __restrict__ W, int ldw, f32x4 (&acc)[4][MR / 32], bf16_t* smem, const int TID) {
    constexpr int JT = MR / 32;
    const int tid = TID, lane = tid & 63, wave = tid >> 6, wr = wave >> 1, wc = wave & 1, l15 = lane & 15, g = lane >> 4;
    const int lrow = tid >> 3, lkc = (tid & 7) * 8;
    const int skc = ((tid & 7) ^ ((lrow >> 1) & 7)) * 8;
    const int rsw = (l15 >> 1) & 7;
    const bf16_t* wp = W + (size_t)lrow * ldw + lkc;
#pragma unroll
    for (int kt = 0; kt < 2; ++kt) {
        u32x4 rw[4];
#pragma unroll
        for (int i = 0; i < 4; ++i) rw[i] = *(const u32x4*)(wp + (size_t)(32 * i) * ldw + kt * 64);
        bf16_t* dw = smem + kt * 2 * LTILE + LTILE;
#pragma unroll
        for (int i = 0; i < 4; ++i) *(u32x4*)(dw + (lrow + 32 * i) * LROW + skc) = rw[i];
    }
    __syncthreads();
#pragma unroll
    for (int kt = 0; kt < 2; ++kt) {
        const bf16_t* sa = smem + kt * 2 * LTILE;
        const bf16_t* sw = sa + LTILE;
#pragma unroll
        for (int ks = 0; ks < 2; ++ks) {
            bf16x8 af[JT], wf[4];
#pragma unroll
            for (int j = 0; j < JT; ++j) af[j] = *(const bf16x8*)(sa + (wr * (MR / 2) + j * 16 + l15) * LROW + ((ks * 4 + g) ^ rsw) * 8);
#pragma unroll
            for (int i = 0; i < 4; ++i) wf[i] = *(const bf16x8*)(sw + (wc * 64 + i * 16 + l15) * LROW + ((ks * 4 + g) ^ rsw) * 8);
#pragma unroll
            for (int i = 0; i < 4; ++i)
#pragma unroll
                for (int j = 0; j < JT; ++j) acc[i][j] = __builtin_amdgcn_mfma_f32_16x16x32_bf16(wf[i], af[j], acc[i][j], 0, 0, 0);
        }
    }
    __syncthreads();
}
template <int JT>
__device__ __forceinline__ void zero_acc(f32x4 (&acc)[4][JT]) {
#pragma unroll
    for (int i = 0; i < 4; ++i)
#pragma unroll
        for (int j = 0; j < JT; ++j) acc[i][j] = (f32x4){0.f, 0.f, 0.f, 0.f};
}
#define TILE_IDS const int lane = TID & 63, wave = TID >> 6, wr = wave >> 1, wc = wave & 1, l15 = lane & 15, g = lane >> 4; (void)lane; (void)wr; (void)wc; (void)l15; (void)g;

struct TrItem { const float* src; bf16_t* dst; int N, k0, n0; };
__device__ __forceinline__ TrItem tr_decode(const Params& p, int item) {
    const int l = item >> 12; int r = item & 4095;
    const float* src; bf16_t* dst; int N;
    bf16_t* w4 = (bf16_t*)(p.ws + OFF_W4) + (size_t)l * 4 * D * D;
    if (r < 2560) { src = p.w_in + (size_t)l * D * INC; dst = (bf16_t*)(p.ws + OFF_WIN) + (size_t)l * INC * D; N = INC; }
    else if (r < 2816) { r -= 2560; src = p.w_conv_out + (size_t)l * D * D; dst = w4; N = D; }
    else if (r < 3072) { r -= 2816; src = p.w_attn_out + (size_t)l * D * D; dst = w4 + (size_t)D * D; N = D; }
    else if (r < 3328) { r -= 3072; src = p.w_four_out + (size_t)l * D * D; dst = w4 + (size_t)2 * D * D; N = D; }
    else if (r < 3584) { r -= 3328; src = p.w_o + (size_t)l * D * D; dst = w4 + (size_t)3 * D * D; N = D; }
    else { r -= 3584; src = p.w_pq + (size_t)l * D * 2048; dst = (bf16_t*)(p.ws + OFF_WPQ) + (size_t)l * 2048 * D; N = 2048; }
    const int ntn = N >> 6, kt = r / ntn, nt = r - kt * ntn;
    TrItem t; t.src = src; t.dst = dst; t.N = N; t.k0 = kt * 64; t.n0 = nt * 64; return t;
}
__device__ __forceinline__ void transpose3(const Params& p, int base, int nitems, float* tiles, const int TID) {
    const int tid = TID, r = tid >> 4, c4 = (tid & 15) * 4;
    float4 v[3][4];
    TrItem t[3];
#pragma unroll
    for (int q = 0; q < 3; ++q) {
        t[q] = tr_decode(p, (base + q) < nitems ? (base + q) : base);
#pragma unroll
        for (int i = 0; i < 4; ++i) v[q][i] = *(const float4*)(t[q].src + (size_t)(t[q].k0 + r + 16 * i) * t[q].N + t[q].n0 + c4);
    }
#pragma unroll
    for (int q = 0; q < 3; ++q)
#pragma unroll
        for (int i = 0; i < 4; ++i) { float* tp = tiles + q * (64 * 65) + (r + 16 * i) * 65 + c4; tp[0] = v[q][i].x; tp[1] = v[q][i].y; tp[2] = v[q][i].z; tp[3] = v[q][i].w; }
    __syncthreads();
#pragma unroll
    for (int q = 0; q < 3; ++q) {
        if (base + q < nitems) {
#pragma unroll
            for (int i = 0; i < 2; ++i) {
                const int cid = tid + 256 * i, n = cid >> 3, kc = cid & 7;
                const float* sp = tiles + q * (64 * 65) + (kc * 8) * 65 + n;
                u32x4 o; o.x = pk2(sp[0], sp[65]); o.y = pk2(sp[2 * 65], sp[3 * 65]); o.z = pk2(sp[4 * 65], sp[5 * 65]); o.w = pk2(sp[6 * 65], sp[7 * 65]);
                *(u32x4*)(t[q].dst + (size_t)(t[q].n0 + n) * D + t[q].k0 + kc * 8) = o;
            }
        }
    }
    __syncthreads();
}

__device__ __forceinline__ void cvt8(const float* __restrict__ src, bf16_t* __restrict__ dst, size_t i8) {
    const float4 a = *(const float4*)(src + i8 * 8), b = *(const float4*)(src + i8 * 8 + 4);
    u32x4 o; o.x = pk2(a.x, a.y); o.y = pk2(a.z, a.w); o.z = pk2(b.x, b.y); o.w = pk2(b.z, b.w);
    *(u32x4*)(dst + i8 * 8) = o;
}

typedef float f32x2v __attribute__((ext_vector_type(2)));
__device__ __forceinline__ unsigned fp8x4(float a, float b, float c, float d) {
    int w = __builtin_amdgcn_cvt_pk_fp8_f32(a, b, 0, false);
    w = __builtin_amdgcn_cvt_pk_fp8_f32(c, d, w, true);
    return (unsigned)w;
}
__device__ __forceinline__ void cvt16_fp8(const float* __restrict__ src, unsigned char* __restrict__ dst, size_t i16, float sc) {
    const float4 a = *(const float4*)(src + i16 * 16), b = *(const float4*)(src + i16 * 16 + 4), c = *(const float4*)(src + i16 * 16 + 8), d = *(const float4*)(src + i16 * 16 + 12);
    u32x4 o; o.x = fp8x4(a.x * sc, a.y * sc, a.z * sc, a.w * sc); o.y = fp8x4(b.x * sc, b.y * sc, b.z * sc, b.w * sc);
    o.z = fp8x4(c.x * sc, c.y * sc, c.z * sc, c.w * sc); o.w = fp8x4(d.x * sc, d.y * sc, d.z * sc, d.w * sc);
    *(u32x4*)(dst + i16 * 16) = o;
}

__device__ __forceinline__ void phase_setup(const Params& p, unsigned char* smem_raw, const int TID) {
    const int tid = TID;
    const size_t gtid = (size_t)blockIdx.x * 256 + tid, gsz = (size_t)gridDim.x * 256;
    float* fs = (float*)smem_raw;
    float* modv = (float*)(p.ws + OFF_MOD);
    for (int item = blockIdx.x; item < 2 * 192; item += gridDim.x) {
        const int l = item / 192, chunk = item - l * 192;
        for (int idx = tid; idx < 3072; idx += 256) {
            const int set = idx >> 10, k = idx & 1023;
            const float cv = set == 0 ? p.c_ctx[k] : p.c[(set - 1) * 1024 + k];
            fs[idx] = cv / (1.f + __expf(-cv));
        }
        __syncthreads();
        const int kq = tid >> 5, cl = tid & 31, n = chunk * 32 + cl;
        const float* wm = p.w_mod + (size_t)l * 1024 * 6144 + n;
        float a0 = 0.f, a1 = 0.f, a2 = 0.f;
#pragma unroll 32
        for (int k = kq * 128; k < kq * 128 + 128; ++k) {
            const float w = wm[(size_t)k * 6144];
            a0 += fs[k] * w; a1 += fs[1024 + k] * w; a2 += fs[2048 + k] * w;
        }
        float* red = fs + 3072;
        red[(kq * 3 + 0) * 32 + cl] = a0; red[(kq * 3 + 1) * 32 + cl] = a1; red[(kq * 3 + 2) * 32 + cl] = a2;
        __syncthreads();
        if (tid < 96) {
            const int set = tid >> 5;
            float sacc = 0.f;
#pragma unroll
            for (int q = 0; q < 8; ++q) sacc += red[(q * 3 + set) * 32 + cl];
            modv[((size_t)l * 3 + set) * 6144 + n] = sacc + p.b_mod[(size_t)l * 6144 + n];
        }
        __syncthreads();
    }
    for (int base = blockIdx.x * 3; base < 8192; base += gridDim.x * 3) transpose3(p, base, 8192, fs, TID);
    {
        const size_t n_p8 = 2ull * 16384 * D / 16;
#pragma unroll 2
        for (size_t i = gtid; i < n_p8; i += gsz) { cvt16_fp8(p.peer_u, p.ws + OFF_PU, i, 64.f); cvt16_fp8(p.peer_v, p.ws + OFF_PV, i, 16.f); }
        const size_t n_sk = 2ull * 8 * 2 * 128 * 128 / 8;
        for (size_t i = gtid; i < n_sk; i += gsz) cvt8(p.sub_keys, (bf16_t*)(p.ws + OFF_SK), i);
        const size_t n_ck = 2ull * 2 * 512 * 1024 / 8;
        for (size_t i = gtid; i < n_ck; i += gsz) cvt8(p.cache_k, (bf16_t*)(p.ws + OFF_CK), i);
        bf16_t* cvt = (bf16_t*)(p.ws + OFF_CVT);
        for (size_t i = gtid; i < n_ck; i += gsz) {
            const int hd = (int)(i & 1023), p8 = (int)((i >> 10) & 63), bl = (int)(i >> 16);
            const float* s = p.cache_v + ((size_t)bl * 512 + p8 * 8) * 1024 + hd;
            u32x4 o; o.x = pk2(s[0], s[1024]); o.y = pk2(s[2048], s[3072]); o.z = pk2(s[4096], s[5120]); o.w = pk2(s[6144], s[7168]);
            *(u32x4*)(cvt + ((size_t)bl * 1024 + hd) * 512 + p8 * 8) = o;
        }
    }
    {
        bf16_t* d1 = (bf16_t*)(p.ws + OFF_D1);
        for (size_t i = gtid; i < 512 * 256; i += gsz) {
            const int cc = (int)(i & 255), m = (int)(i >> 8), pq = m >> 8, cp = m & 255, idx = (cc * cp) & 255;
            const float ang = (float)idx * (1.f / 128.f);
            const float v = (pq ? sinpif(ang) : cospif(ang)) * (1.f / 16.f);
            d1[i] = (bf16_t)(pk2(v, 0.f) & 0xffffu);
        }
        bf16_t* a2c = (bf16_t*)(p.ws + OFF_A2C);
        for (size_t i = gtid; i < 256 * 512; i += gsz) {
            const int k = (int)(i & 511), sp = (int)(i >> 9), pq = k >> 8, s = k & 255, idx = (s * sp) & 255;
            const float ang = (float)idx * (1.f / 128.f);
            const float v = (pq ? -sinpif(ang) : cospif(ang)) * (1.f / 16.f);
            a2c[i] = (bf16_t)(pk2(v, 0.f) & 0xffffu);
        }
        bf16_t* a2l = (bf16_t*)(p.ws + OFF_A2L);
        for (size_t i = gtid; i < 1024 * 2048; i += gsz) {
            const int k = (int)(i & 2047), sp = (int)(i >> 11), pq = k >> 10, s = k & 1023, idx = (s * sp) & 1023;
            const float ang = (float)idx * (1.f / 512.f);
            const float v = (pq ? -sinpif(ang) : cospif(ang)) * (1.f / 32.f);
            a2l[i] = (bf16_t)(pk2(v, 0.f) & 0xffffu);
        }
    }
}

__device__ __forceinline__ const float* x_in_row(const Params& p, int t) { return t < TC ? p.x_prompt + (size_t)t * D : p.x_sample + (size_t)(t - TC) * D; }
__device__ __forceinline__ void phase_norm(const Params& p, const float* __restrict__ gw, const float* __restrict__ modl, int shift_i, int scale_i, const int TID, bool from_inputs = false) {
    const int lane = TID & 63, wave = TID >> 6;
    const float* x = (const float*)(p.ws + OFF_X);
    bf16_t* h = (bf16_t*)(p.ws + OFF_H);
    for (int tok = blockIdx.x * 4 + wave; tok < T; tok += gridDim.x * 4) {
        float4 v[4]; float ss = 0.f;
        const float* xr = from_inputs ? x_in_row(p, tok) : x + (size_t)tok * D;
#pragma unroll
        for (int i = 0; i < 4; ++i) { v[i] = *(const float4*)(xr + i * 256 + lane * 4); ss += v[i].x * v[i].x + v[i].y * v[i].y + v[i].z * v[i].z + v[i].w * v[i].w; }
        ss = wave_sum(ss, lane);
        const float rstd = rsqrtf(ss * (1.f / D) + RMS_EPS);
        const float* ms = modl + (size_t)tok_set(tok) * 6144;
#pragma unroll
        for (int i = 0; i < 4; ++i) {
            const int n = i * 256 + lane * 4;
            const float4 gg = *(const float4*)(gw + n), sc = *(const float4*)(ms + scale_i * 1024 + n), sh = *(const float4*)(ms + shift_i * 1024 + n);
            f32x4 y;
            y[0] = v[i].x * rstd * gg.x * (1.f + sc.x) + sh.x; y[1] = v[i].y * rstd * gg.y * (1.f + sc.y) + sh.y;
            y[2] = v[i].z * rstd * gg.z * (1.f + sc.z) + sh.z; y[3] = v[i].w * rstd * gg.w * (1.f + sc.w) + sh.w;
            *(u32x2*)(h + (size_t)tok * D + n) = pk4(y);
        }
    }
}

__device__ __forceinline__ void phase_g1(const Params& p, int l, bf16_t* smem, const int TID) {
    TILE_IDS
    const bf16_t* h = (const bf16_t*)(p.ws + OFF_H);
    const bf16_t* wt = (const bf16_t*)(p.ws + OFF_WIN) + (size_t)l * INC * D;
    bf16_t* z = (bf16_t*)(p.ws + OFF_Z);
    bf16_t* vt = (bf16_t*)(p.ws + OFF_VT);
    float* out_k = p.out + (size_t)T * D;
    float* out_v = out_k + (size_t)16 * 2 * 256 * 1024;
    for (int item = blockIdx.x; item < 48 * 80; item += gridDim.x) {
        const int tn = item / 48, tm = item - tn * 48, a0 = tm * 128, n0 = tn * 128;
        f32x4 acc[4][4]; zero_acc(acc);
        gemm_tile<128, 2>(h + (size_t)a0 * D, D, wt + (size_t)n0 * D, D, D, acc, smem, TID);
#pragma unroll
        for (int j = 0; j < 4; ++j) {
            const int a = a0 + wr * 64 + j * 16 + l15;
#pragma unroll
            for (int i = 0; i < 4; ++i) {
                const int n = n0 + wc * 64 + i * 16 + 4 * g;
                const f32x4 v = acc[i][j];
                *(u32x2*)(z + (size_t)a * INC + n) = pk4(v);
                if (n0 >= 4096 && n0 < 5120) {
                    if (a < TC) { const int b = a >> 8, s = a & 255; *(f32x4*)(out_k + ((size_t)(b * 2 + l) * 256 + s) * 1024 + (n - 4096)) = v; }
                } else if (n0 >= 5120 && n0 < 6144) {
                    const int hd = n - 5120;
                    if (a < TC) {
                        const int b = a >> 8, s = a & 255;
                        *(f32x4*)(out_v + ((size_t)(b * 2 + l) * 256 + s) * 1024 + hd) = v;
                        bf16_t* vp = vt + ((size_t)b * 1024 + hd) * 256 + s;
                        const u32x2 pk = pk4(v);
                        vp[0] = (bf16_t)(pk.x & 0xffff); vp[256] = (bf16_t)(pk.x >> 16); vp[512] = (bf16_t)(pk.y & 0xffff); vp[768] = (bf16_t)(pk.y >> 16);
                    } else {
                        const int b = (a - TC) >> 10, s = (a - TC) & 1023;
                        bf16_t* vp = vt + (size_t)16 * 1024 * 256 + ((size_t)b * 1024 + hd) * 1024 + s;
                        const u32x2 pk = pk4(v);
                        vp[0] = (bf16_t)(pk.x & 0xffff); vp[1024] = (bf16_t)(pk.x >> 16); vp[2048] = (bf16_t)(pk.y & 0xffff); vp[3072] = (bf16_t)(pk.y >> 16);
                    }
                }
            }
        }
    }
}

__device__ __forceinline__ void phase_mix(const Params& p, int l, bf16_t* smem, const int TID) {
    TILE_IDS
    const bf16_t* z = (const bf16_t*)(p.ws + OFF_Z);
    const bf16_t* vt = (const bf16_t*)(p.ws + OFF_VT);
    bf16_t* att = (bf16_t*)(p.ws + OFF_ATT);
    constexpr int N_LAT = 512, N_CTX = 512, N_F1 = 768;
    for (int item = blockIdx.x; item < N_LAT + N_CTX; item += gridDim.x) {
        {
            const bool lat = item < N_LAT;
            int b, hh, qpos0, tb, hv = 0, r = 0, r0 = 0, nsub;
            const bf16_t* kbase; const bf16_t* vbase; size_t kstride, ksub; int vstride, vsub;
            if (lat) {
                hv = item >> 8; const int it2 = item & 255;
                const int grp = (it2 & 7) + 8 * (it2 >> 7);
                r = (it2 >> 3) & 15; b = grp >> 3; hh = grp & 7;
                tb = TC + b * 1024; qpos0 = r * 64 + wave * 16; nsub = 8;
                r0 = r - 4; r0 = r0 < 0 ? 0 : (r0 > 8 ? 8 : r0);
                if (hv == 0) {
                    kbase = z + (size_t)(tb + r0 * 64) * INC + 4096 + hh * 128; kstride = INC; ksub = (size_t)64 * INC;
                    vbase = vt + (size_t)16 * 1024 * 256 + ((size_t)b * 1024 + hh * 128) * 1024 + r0 * 64; vstride = 1024; vsub = 64;
                } else {
                    kbase = (const bf16_t*)(p.ws + OFF_CK) + ((size_t)(b * 2 + l) * 512) * 1024 + hh * 128; kstride = 1024; ksub = (size_t)64 * 1024;
                    vbase = (const bf16_t*)(p.ws + OFF_CVT) + ((size_t)(b * 2 + l) * 1024 + hh * 128) * 512; vstride = 512; vsub = 64;
                }
            } else {
                const int it = item - N_LAT, grp = (it & 7) + 8 * (it >> 5), qb = (it >> 3) & 3;
                b = grp >> 3; hh = grp & 7;
                tb = b * 256; qpos0 = qb * 64 + wave * 16; nsub = 4;
                kbase = z + (size_t)tb * INC + 4096 + hh * 128; kstride = INC; ksub = (size_t)64 * INC;
                vbase = vt + ((size_t)b * 1024 + hh * 128) * 256; vstride = 256; vsub = 64;
            }
            const bool loc = lat && hv == 0;
            const float* rpb_h = p.rpb + ((size_t)l * 8 + hh) * 15 * 31;
            bf16_t* Ks = smem;
            bf16_t* Vs = smem + 64 * 128;
            bf16_t* pl = smem + 2 * 64 * 128 + wave * (16 * 72);
            bf16x8 qf[4];
            {
                const bf16_t* qp = z + (size_t)(tb + qpos0 + l15) * INC + 3072 + hh * 128 + g * 8;
#pragma unroll
                for (int ks = 0; ks < 4; ++ks) qf[ks] = *(const bf16x8*)(qp + ks * 32);
            }
            float m = -3.0e38f, lsum = 0.f;
            f32x4 o[8];
#pragma unroll
            for (int dt = 0; dt < 8; ++dt) o[dt] = (f32x4){0.f, 0.f, 0.f, 0.f};
            u32x4 rk[4], rv[4];
            const int tid = TID;
#define AT_LOAD(I) do { const bf16_t* kb_ = kbase + (size_t)(I) * ksub; const bf16_t* vb_ = vbase + (size_t)(I) * vsub; \
                _Pragma("unroll") for (int e = 0; e < 4; ++e) { const int id_ = tid + 256 * e; \
                    rk[e] = *(const u32x4*)(kb_ + (size_t)(id_ >> 4) * kstride + (id_ & 15) * 8); \
                    rv[e] = *(const u32x4*)(vb_ + (size_t)(id_ >> 3) * vstride + (id_ & 7) * 8); } } while (0)
#define AT_STORE() do { _Pragma("unroll") for (int e = 0; e < 4; ++e) { const int id_ = tid + 256 * e; \
                    { const int key_ = id_ >> 4, ch_ = id_ & 15; *(u32x4*)(Ks + key_ * 128 + ((ch_ ^ (key_ & 15)) * 8)) = rk[e]; } \
                    { const int d_ = id_ >> 3, ch_ = id_ & 7; *(u32x4*)(Vs + d_ * 64 + ((ch_ ^ ((d_ >> 1) & 7)) * 8)) = rv[e]; } } } while (0)
            AT_LOAD(0);
            float* rpl = (float*)(smem + 2 * 64 * 128 + 4 * 16 * 72);
            if (loc) { for (int idx = tid; idx < 15 * 31; idx += 256) rpl[idx] = rpb_h[idx]; }
            AT_STORE();
            __syncthreads();
            const float SC2 = 0.08838834764831845f * 1.4426950408889634f;
#pragma unroll 1
            for (int i = 0; i < nsub; ++i) {
                if (i + 1 < nsub) AT_LOAD(i + 1);
                f32x4 st[4];
#pragma unroll
                for (int nt = 0; nt < 4; ++nt) {
                    f32x4 a4 = (f32x4){0.f, 0.f, 0.f, 0.f};
#pragma unroll
                    for (int ks = 0; ks < 4; ++ks) {
                        const bf16x8 kf = *(const bf16x8*)(Ks + (nt * 16 + l15) * 128 + (((ks * 4 + g) ^ l15) * 8));
                        a4 = __builtin_amdgcn_mfma_f32_16x16x32_bf16(kf, qf[ks], a4, 0, 0, 0);
                    }
                    st[nt] = a4 * SC2;
                    if (nt & 1) __builtin_amdgcn_sched_barrier(0);
                }
                if (loc) {
                    int qc = wave * 16 + l15; asm volatile("" : "+v"(qc));
                    int c0 = qc - 8; c0 = c0 < 0 ? 0 : (c0 > 48 ? 48 : c0);
                    const float* rp = rpl + (r0 + i - r + 7) * 31;
#pragma unroll
                    for (int nt = 0; nt < 4; ++nt) {
#pragma unroll
                        for (int jj = 0; jj < 4; ++jj) {
                            const int kc = nt * 16 + 4 * g + jj;
                            const bool inw = (kc >= c0) && (kc < c0 + 16);
                            int dc = kc - qc + 15; dc = dc < 0 ? 0 : (dc > 30 ? 30 : dc);
                            st[nt][jj] = inw ? (st[nt][jj] + rp[dc] * 1.4426950408889634f) : -1.0e30f;
                        }
                    }
                }
                float cmax = -3.0e38f;
#pragma unroll
                for (int nt = 0; nt < 4; ++nt) cmax = fmaxf(fmaxf(cmax, fmaxf(st[nt][0], st[nt][1])), fmaxf(st[nt][2], st[nt][3]));
                cmax = fmaxf(cmax, SHFL_XOR(cmax, 16)); cmax = fmaxf(cmax, SHFL_XOR(cmax, 32));
                const float mn = fmaxf(m, cmax), alpha = __builtin_amdgcn_exp2f(m - mn);
                m = mn;
                float ps = 0.f;
#pragma unroll
                for (int nt = 0; nt < 4; ++nt) {
                    f32x4 pv;
#pragma unroll
                    for (int jj = 0; jj < 4; ++jj) { pv[jj] = __builtin_amdgcn_exp2f(st[nt][jj] - mn); ps += pv[jj]; }
                    *(u32x2*)(pl + l15 * 72 + nt * 16 + 4 * g) = pk4(pv);
                }
                ps += SHFL_XOR(ps, 16); ps += SHFL_XOR(ps, 32);
                lsum = lsum * alpha + ps;
#pragma unroll
                for (int dt = 0; dt < 8; ++dt) o[dt] = o[dt] * alpha;
                __builtin_amdgcn_wave_barrier();
                bf16x8 pf[2];
#pragma unroll
                for (int ks = 0; ks < 2; ++ks) pf[ks] = *(const bf16x8*)(pl + l15 * 72 + ks * 32 + g * 8);
#pragma unroll
                for (int dt = 0; dt < 8; ++dt) {
#pragma unroll
                    for (int ks = 0; ks < 2; ++ks) {
                        const bf16x8 vf = *(const bf16x8*)(Vs + (dt * 16 + l15) * 64 + (((ks * 4 + g) ^ ((l15 >> 1) & 7)) * 8));
                        o[dt] = __builtin_amdgcn_mfma_f32_16x16x32_bf16(vf, pf[ks], o[dt], 0, 0, 0);
                    }
                    if ((dt & 3) == 3) __builtin_amdgcn_sched_barrier(0);
                }
                __syncthreads();
                if (i + 1 < nsub) { AT_STORE(); __syncthreads(); }
            }
#undef AT_LOAD
#undef AT_STORE
            if (lat) {
                float* pp = (float*)(p.ws + OFF_Q) + ((size_t)(((b * 8 + hh) * 1024 + qpos0 + l15) * 2 + hv)) * 132;
#pragma unroll
                for (int dt = 0; dt < 8; ++dt) *(f32x4*)(pp + dt * 16 + 4 * g) = o[dt];
                if (g == 0) { pp[128] = m; pp[129] = lsum; }
            } else {
                const float inv = 1.f / lsum;
                bf16_t* op = att + (size_t)(tb + qpos0 + l15) * D + hh * 128 + 4 * g;
#pragma unroll
                for (int dt = 0; dt < 8; ++dt) *(u32x2*)(op + dt * 16) = pk4(o[dt] * inv);
            }
            __syncthreads();
        }
    }
    for (int item = N_LAT + N_CTX + blockIdx.x; item < N_LAT + N_CTX + N_F1; item += gridDim.x) {
        {
            int it = item - (N_LAT + N_CTX);
            int S, bg, mt, nt, tb; size_t pbase;
            if (it < 512) { S = 256; bg = it >> 3; mt = (it >> 1) & 3; nt = it & 1; tb = (bg >> 2) * 256; pbase = (size_t)bg * 256 * 512; }
            else { it -= 512; S = 1024; bg = it >> 5; mt = (it >> 3) & 3; nt = it & 7; tb = TC + (bg >> 2) * 1024; pbase = (size_t)64 * 256 * 512 + (size_t)bg * 256 * 2048; }
            const int gq = bg & 3;
            f32x4 acc[4][4]; zero_acc(acc);
            gemm_tile<128>((const bf16_t*)(p.ws + OFF_D1) + (size_t)mt * 128 * 256, 256, z + (size_t)(tb + nt * 128) * INC + 6144 + gq * 256, INC, 256, acc, smem, TID);
            bf16_t* pqt = (bf16_t*)(p.ws + OFF_PQT) + pbase;
#pragma unroll
            for (int j = 0; j < 4; ++j) {
                const int a = mt * 128 + wr * 64 + j * 16 + l15, pq = a >> 8, cp = a & 255;
#pragma unroll
                for (int i = 0; i < 4; ++i) {
                    const int s = nt * 128 + wc * 64 + i * 16 + 4 * g;
                    *(u32x2*)(pqt + (size_t)cp * (2 * S) + pq * S + s) = pk4(acc[i][j]);
                }
            }
        }
    }
    {
        bf16_t* aconv = (bf16_t*)(p.ws + OFF_ACONV);
        const float* cw = p.conv_w + (size_t)l * 3 * 1024;
        for (size_t i = (size_t)blockIdx.x * 256 + TID; i < (size_t)T * 128; i += (size_t)gridDim.x * 256) {
            const int t = (int)(i >> 7), c = (int)(i & 127) * 8;
            const int s = t < TC ? (t & 255) : ((t - TC) & 1023), S = t < TC ? 256 : 1024;
            const bf16_t* zr = z + (size_t)t * INC + c;
            const u32x4 cb = *(const u32x4*)zr;
            const u32x4 c1 = *(const u32x4*)(zr + 1024), x1 = *(const u32x4*)(zr + 2048);
            u32x4 c0 = (u32x4){0, 0, 0, 0}, x0 = c0, c2 = c0, x2 = c0;
            if (s > 0) { c0 = *(const u32x4*)(zr - INC + 1024); x0 = *(const u32x4*)(zr - INC + 2048); }
            if (s + 1 < S) { c2 = *(const u32x4*)(zr + INC + 1024); x2 = *(const u32x4*)(zr + INC + 2048); }
            u32x4 o;
#pragma unroll
            for (int e = 0; e < 4; ++e) {
                const float w0a = cw[c + 2 * e], w0b = cw[c + 2 * e + 1], w1a = cw[1024 + c + 2 * e], w1b = cw[1024 + c + 2 * e + 1], w2a = cw[2048 + c + 2 * e], w2b = cw[2048 + c + 2 * e + 1];
                const float ua = w0a * bf_lo(c0[e]) * bf_lo(x0[e]) + w1a * bf_lo(c1[e]) * bf_lo(x1[e]) + w2a * bf_lo(c2[e]) * bf_lo(x2[e]);
                const float ub = w0b * bf_hi(c0[e]) * bf_hi(x0[e]) + w1b * bf_hi(c1[e]) * bf_hi(x1[e]) + w2b * bf_hi(c2[e]) * bf_hi(x2[e]);
                o[e] = pk2(bf_lo(cb[e]) * ua, bf_hi(cb[e]) * ub);
            }
            *(u32x4*)(aconv + (size_t)t * D + c) = o;
        }
    }
}

__device__ __forceinline__ void phase_f2(const Params& p, bf16_t* smem, const int TID) {
    TILE_IDS
    bf16_t* four = (bf16_t*)(p.ws + OFF_FOUR);
    {
        const float* part = (const float*)(p.ws + OFF_Q);
        bf16_t* att = (bf16_t*)(p.ws + OFF_ATT);
        for (size_t i = (size_t)blockIdx.x * 256 + TID; i < (size_t)2 * 8 * 1024 * 32; i += (size_t)gridDim.x * 256) {
            const int d4 = (int)(i & 31), bhq = (int)(i >> 5), qpos = bhq & 1023, bh = bhq >> 10, bb = bh >> 3, hh = bh & 7;
            const float* p0 = part + (size_t)bhq * 2 * 132, *p1 = p0 + 132;
            const float m0 = p0[128], l0 = p0[129], m1 = p1[128], l1 = p1[129];
            const float mm = fmaxf(m0, m1), w0 = __builtin_amdgcn_exp2f(m0 - mm), w1 = __builtin_amdgcn_exp2f(m1 - mm);
            const float inv = 1.f / (w0 * l0 + w1 * l1);
            const f32x4 a0 = *(const f32x4*)(p0 + d4 * 4), a1 = *(const f32x4*)(p1 + d4 * 4);
            *(u32x2*)(att + (size_t)(TC + bb * 1024 + qpos) * D + hh * 128 + d4 * 4) = pk4((a0 * w0 + a1 * w1) * inv);
        }
    }
    for (int item = blockIdx.x; item < 512; item += gridDim.x) {
        if (item < 256) {
            const int bg = item >> 5, mt = (item >> 1) & 15, nt = item & 1, tb = TC + (bg >> 2) * 1024, gq = bg & 3;
            const size_t pbase = (size_t)64 * 256 * 512 + (size_t)bg * 256 * 2048;
            f32x4 acc[4][2]; zero_acc(acc);
            gemm_tile<64>((const bf16_t*)(p.ws + OFF_A2L) + (size_t)mt * 64 * 2048, 2048, (const bf16_t*)(p.ws + OFF_PQT) + pbase + (size_t)nt * 128 * 2048, 2048, 2048, acc, smem, TID);
#pragma unroll
            for (int j = 0; j < 2; ++j) {
                const int a = tb + mt * 64 + wr * 32 + j * 16 + l15;
#pragma unroll
                for (int i = 0; i < 4; ++i) *(u32x2*)(four + (size_t)a * D + gq * 256 + nt * 128 + wc * 64 + i * 16 + 4 * g) = pk4(acc[i][j]);
            }
        } else {
            const int it = item - 256, bg = it >> 2, mt = (it >> 1) & 1, nt = it & 1, tb = (bg >> 2) * 256, gq = bg & 3;
            const size_t pbase = (size_t)bg * 256 * 512;
            f32x4 acc[4][4]; zero_acc(acc);
            gemm_tile<128>((const bf16_t*)(p.ws + OFF_A2C) + (size_t)mt * 128 * 512, 512, (const bf16_t*)(p.ws + OFF_PQT) + pbase + (size_t)nt * 128 * 512, 512, 512, acc, smem, TID);
#pragma unroll
            for (int j = 0; j < 4; ++j) {
                const int a = tb + mt * 128 + wr * 64 + j * 16 + l15;
#pragma unroll
                for (int i = 0; i < 4; ++i) *(u32x2*)(four + (size_t)a * D + gq * 256 + nt * 128 + wc * 64 + i * 16 + 4 * g) = pk4(acc[i][j]);
            }
        }
    }
}

__device__ __forceinline__ void phase_g3(const Params& p, int l, bf16_t* smem, const int TID) {
    TILE_IDS
    const bf16_t* z = (const bf16_t*)(p.ws + OFF_Z);
    const bf16_t* w4 = (const bf16_t*)(p.ws + OFF_W4) + (size_t)l * 4 * D * D;
    bf16_t* merged = (bf16_t*)(p.ws + OFF_MERGED);
    for (int item = blockIdx.x; item < 64 * 8; item += gridDim.x) {
        const int tn = item >> 6, tm = item & 63, a0 = tm * 96, n0 = tn * 128;
        f32x4 macc[4][3]; zero_acc(macc);
#pragma unroll 1
        for (int br = 0; br < 3; ++br) {
            const bf16_t* A = (const bf16_t*)(p.ws + OFF_ACONV + (size_t)br * SZ_TD2);
            f32x4 acc[4][3]; zero_acc(acc);
            gemm_tile<96, 1>(A + (size_t)a0 * D, D, w4 + (size_t)br * D * D + (size_t)n0 * D, D, D, acc, smem, TID);
#pragma unroll
            for (int j = 0; j < 3; ++j) {
                const int a = a0 + wr * 48 + j * 16 + l15;
#pragma unroll
                for (int i = 0; i < 4; ++i) {
                    const int n = n0 + wc * 64 + i * 16 + 4 * g;
                    const u32x2 gz = *(const u32x2*)(z + (size_t)a * INC + 7168 + br * 1024 + n);
                    const float g0 = 1.f / (1.f + __expf(-bf_lo(gz.x))), g1 = 1.f / (1.f + __expf(-bf_hi(gz.x)));
                    const float g2 = 1.f / (1.f + __expf(-bf_lo(gz.y))), g3 = 1.f / (1.f + __expf(-bf_hi(gz.y)));
                    macc[i][j][0] += g0 * acc[i][j][0]; macc[i][j][1] += g1 * acc[i][j][1]; macc[i][j][2] += g2 * acc[i][j][2]; macc[i][j][3] += g3 * acc[i][j][3];
                }
            }
        }
#pragma unroll
        for (int j = 0; j < 3; ++j) {
            const int a = a0 + wr * 48 + j * 16 + l15;
#pragma unroll
            for (int i = 0; i < 4; ++i) *(u32x2*)(merged + (size_t)a * D + n0 + wc * 64 + i * 16 + 4 * g) = pk4(macc[i][j]);
        }
    }
}

__device__ __forceinline__ void phase_g4(const Params& p, int l, bf16_t* smem, const int TID) {
    TILE_IDS
    const bf16_t* merged = (const bf16_t*)(p.ws + OFF_MERGED);
    const bf16_t* wo = (const bf16_t*)(p.ws + OFF_W4) + ((size_t)l * 4 + 3) * D * D;
    const float* modl = (const float*)(p.ws + OFF_MOD) + (size_t)l * 3 * 6144;
    float* x = (float*)(p.ws + OFF_X);
    for (int item = blockIdx.x; item < 64 * 8; item += gridDim.x) {
        const int tn = item >> 6, tm = item & 63, a0 = tm * 96, n0 = tn * 128;
        f32x4 acc[4][3]; zero_acc(acc);
        gemm_tile<96>(merged + (size_t)a0 * D, D, wo + (size_t)n0 * D, D, D, acc, smem, TID);
#pragma unroll
        for (int j = 0; j < 3; ++j) {
            const int a = a0 + wr * 48 + j * 16 + l15;
            const float* g1p = modl + (size_t)tok_set(a) * 6144 + 2 * 1024;
#pragma unroll
            for (int i = 0; i < 4; ++i) {
                const int n = n0 + wc * 64 + i * 16 + 4 * g;
                const f32x4 gt = *(const f32x4*)(g1p + n);
                f32x4* xp = (f32x4*)(x + (size_t)a * D + n);
                const f32x4 xold = (l == 0) ? *(const f32x4*)(x_in_row(p, a) + n) : *xp;
                *xp = xold + gt * acc[i][j];
            }
        }
    }
}

constexpr int SROW = 128;
__device__ __forceinline__ unsigned umax(unsigned a, unsigned b) { return a > b ? a : b; }
__device__ __forceinline__ unsigned umin(unsigned a, unsigned b) { return a > b ? b : a; }
__device__ __forceinline__ void sort16_desc(unsigned (&k)[16]) {
#pragma unroll
    for (int size = 2; size <= 16; size <<= 1) {
#pragma unroll
        for (int stride = size >> 1; stride > 0; stride >>= 1) {
#pragma unroll
            for (int i = 0; i < 16; ++i) {
                const int j = i ^ stride;
                if (j > i) {
                    const bool desc = (i & size) == 0;
                    const unsigned hi = umax(k[i], k[j]), lo = umin(k[i], k[j]);
                    k[i] = desc ? hi : lo; k[j] = desc ? lo : hi;
                }
            }
        }
    }
}
__device__ __forceinline__ void merge16(unsigned (&lst)[16], const unsigned (&nw)[16]) {
#pragma unroll
    for (int i = 0; i < 16; ++i) lst[i] = umax(lst[i], nw[15 - i]);
#pragma unroll
    for (int stride = 8; stride > 0; stride >>= 1) {
#pragma unroll
        for (int i = 0; i < 16; ++i) {
            const int j = i ^ stride;
            if (j > i) { const unsigned hi = umax(lst[i], lst[j]), lo = umin(lst[i], lst[j]); lst[i] = hi; lst[j] = lo; }
        }
    }
}
__device__ __forceinline__ void topk_half(const float* sc, unsigned* exch, unsigned (&lst)[16], const int TID) {
    const int tid = TID, row = tid >> 1, half = tid & 1;
    const float* rp = sc + row * SROW;
    const bool live = row < 96;
#pragma unroll 1
    for (int grp = 0; grp < (live ? 4 : 0); ++grp) {
        unsigned nw[16];
#pragma unroll
        for (int e4 = 0; e4 < 4; ++e4) {
            const int e = grp * 4 + e4;
            const f32x4 v = *(const f32x4*)(rp + (((2 * e + half) ^ (row & 31)) << 2));
            const unsigned n = (unsigned)(e * 8 + half * 4);
#pragma unroll
            for (int c = 0; c < 4; ++c) nw[e4 * 4 + c] = (f2key(v[c]) & 0xffffff80u) | (n + c);
        }
        sort16_desc(nw);
        if (grp == 0) {
#pragma unroll
            for (int j = 0; j < 16; ++j) lst[j] = nw[j];
        } else merge16(lst, nw);
    }
    __syncthreads();
    if (half && live) {
#pragma unroll
        for (int j = 0; j < 16; ++j) exch[row * 16 + j] = lst[j];
    }
    __syncthreads();
    if (!half && live) {
        unsigned nw[16];
#pragma unroll
        for (int j = 0; j < 16; ++j) nw[j] = exch[row * 16 + j];
        merge16(lst, nw);
    }
    __syncthreads();
}

__device__ __forceinline__ void phase_g5(const Params& p, int l, bf16_t* smem, const int TID) {
    TILE_IDS
    const bf16_t* h2 = (const bf16_t*)(p.ws + OFF_H);
    const bf16_t* wpq = (const bf16_t*)(p.ws + OFF_WPQ) + (size_t)l * 2048 * D;
    const bf16_t* sk = (const bf16_t*)(p.ws + OFF_SK) + (size_t)l * 8 * 2 * 128 * 128;
    bf16_t* q = (bf16_t*)(p.ws + OFF_Q);
    int* eidx = (int*)(p.ws + OFF_EIDX);
    float* gate = (float*)(p.ws + OFF_GATE);
    float* sc = (float*)smem;
    unsigned* exch = (unsigned*)smem;
    for (int item = blockIdx.x; item < 64 * 8; item += gridDim.x) {
        const int head = item >> 6, tm = item & 63, a0 = tm * 96;
        unsigned l0[16], l1[16];
#pragma unroll
        for (int pp = 0; pp < 2; ++pp) {
            const int c0 = (head * 2 + pp) * 128;
            {
                f32x4 acc[4][3]; zero_acc(acc);
                gemm_tile<96, 0>(h2 + (size_t)a0 * D, D, wpq + (size_t)c0 * D, D, D, acc, smem, TID);
#pragma unroll
                for (int j = 0; j < 3; ++j) {
                    const int a = wr * 48 + j * 16 + l15;
#pragma unroll
                    for (int i = 0; i < 4; ++i) {
                        const int chunk = 2 * i + (g >> 1);
                        *(u32x2*)(smem + wc * 2 * LTILE + a * LROW + ((chunk ^ ((a >> 1) & 7)) * 8) + (g & 1) * 4) = pk4(acc[i][j]);
                    }
                }
            }
            {
                f32x4 acc[4][3]; zero_acc(acc);
                gemm_tile_lds_act<96>(sk + (size_t)(head * 2 + pp) * 128 * 128, 128, acc, smem, TID);
#pragma unroll
                for (int j = 0; j < 3; ++j) {
                    const int a = wr * 48 + j * 16 + l15;
#pragma unroll
                    for (int i = 0; i < 4; ++i) *(f32x4*)(sc + a * SROW + (((wc * 16 + i * 4 + g) ^ (a & 31)) << 2)) = acc[i][j];
                }
            }
            __syncthreads();
            if (pp == 0) topk_half(sc, exch, l0, TID); else topk_half(sc, exch, l1, TID);
        }
        const int tid = TID, row = tid >> 1, half = tid & 1;
        unsigned* lsts = (unsigned*)smem;
        if (!half && row < 96) {
#pragma unroll
            for (int j = 0; j < 16; ++j) { lsts[row * 32 + j] = l0[j]; lsts[row * 32 + 16 + j] = l1[j]; }
        }
        __syncthreads();
        if (!half && row < 96) {
            float s1[16], s2[16];
#pragma unroll
            for (int j = 0; j < 16; ++j) { s1[j] = key2f(l0[j] & 0xffffff80u); s2[j] = key2f(l1[j] & 0xffffff80u); }
#define CAND(a, b) ((f2key(s1[a] + s2[b]) & 0xffffff00u) | (unsigned)((a) * 16 + (b)))
            unsigned cl[16];
#pragma unroll
            for (int b = 0; b < 16; ++b) cl[b] = CAND(0, b);
            {
                unsigned nw[16] = {CAND(1, 0), CAND(1, 1), CAND(1, 2), CAND(1, 3), CAND(1, 4), CAND(1, 5), CAND(1, 6), CAND(1, 7),
                                   CAND(2, 0), CAND(2, 1), CAND(2, 2), CAND(2, 3), CAND(2, 4), CAND(3, 0), CAND(3, 1), CAND(3, 2)};
                sort16_desc(nw); merge16(cl, nw);
            }
            {
                unsigned nw[16] = {CAND(3, 3), CAND(4, 0), CAND(4, 1), CAND(4, 2), CAND(5, 0), CAND(5, 1), CAND(6, 0), CAND(6, 1),
                                   CAND(7, 0), CAND(7, 1), CAND(8, 0), CAND(9, 0), CAND(10, 0), CAND(11, 0), CAND(12, 0), CAND(13, 0)};
                sort16_desc(nw); merge16(cl, nw);
            }
            {
                unsigned nw[16] = {CAND(14, 0), CAND(15, 0), 0u, 0u, 0u, 0u, 0u, 0u, 0u, 0u, 0u, 0u, 0u, 0u, 0u, 0u};
                merge16(cl, nw);
            }
#undef CAND
            const float mx = key2f(cl[0] & 0xffffff00u);
            float ev[16], es = 0.f;
#pragma unroll
            for (int j = 0; j < 16; ++j) { ev[j] = __expf(key2f(cl[j] & 0xffffff00u) - mx); es += ev[j]; }
            const float inv = 1.f / es;
            const size_t ob = (size_t)(a0 + row) * 128 + head * 16;
#pragma unroll
            for (int j = 0; j < 16; ++j) {
                const unsigned ab = cl[j] & 0xffu;
                const unsigned i1 = lsts[row * 32 + (ab >> 4)] & 127u, i2 = lsts[row * 32 + 16 + (ab & 15u)] & 127u;
                eidx[ob + j] = (int)(i1 * 128u + i2);
                gate[ob + j] = ev[j] * inv;
            }
        }
        __syncthreads();
    }
}

__device__ __forceinline__ void peer_load(const unsigned char* __restrict__ tab, int e0, int e1, int gi, int lane, u32x4 (&w)[8]) {
    const int ecur = gi < 8 ? e0 : e1, sbase = (gi & 7) * 8;
#pragma unroll
    for (int k = 0; k < 8; ++k) w[k] = *(const u32x4*)(tab + (size_t)__builtin_amdgcn_readlane(ecur, sbase + k) * D + lane * 16);
}
__device__ __forceinline__ float gelu_bf(float v) {
    const float av = __builtin_fabsf(v), t = __builtin_amdgcn_rcpf(av * 0.2316418882f + 1.0f);
    float q = t * 0.5307027145f + (-0.7265760135f); q = q * t + 0.7107068705f; q = q * t + (-0.142248368f); q = q * t + 0.127414796f; q = q * t;
    const float e = __builtin_amdgcn_exp2f((v * v) * (-0.72134752044f));
    const float m = v * (q * e), r = v - m;
    return v < 0.f ? m : r;
}
__device__ __forceinline__ float peer_dots(const u32x4 (&uw)[8], const f32x2v (&hf2)[8], float g0, float g1, int gi, int lane, int kperm) {
    float pd[8];
#pragma unroll
    for (int k = 0; k < 8; ++k) {
        f32x2v s2 = (f32x2v){0.f, 0.f};
#pragma unroll
        for (int d = 0; d < 4; ++d) {
            const f32x2v lo = __builtin_amdgcn_cvt_pk_f32_fp8((int)uw[k][d], false), hi = __builtin_amdgcn_cvt_pk_f32_fp8((int)uw[k][d], true);
            s2 += lo * hf2[2 * d]; s2 += hi * hf2[2 * d + 1];
        }
        pd[k] = s2.x + s2.y;
    }
    float q4[4], r2[2], s1;
    {
        const bool b0 = lane & 1;
#pragma unroll
        for (int i = 0; i < 4; ++i) { const float snd = b0 ? pd[i] : pd[4 + i]; const float rcv = SHFL_XOR(snd, 1); q4[i] = (b0 ? pd[4 + i] : pd[i]) + rcv; }
        const bool b1 = lane & 2;
#pragma unroll
        for (int i = 0; i < 2; ++i) { const float snd = b1 ? q4[i] : q4[2 + i]; const float rcv = SHFL_XOR(snd, 2); r2[i] = (b1 ? q4[2 + i] : q4[i]) + rcv; }
        const bool b2 = lane & 4;
        { const float snd = b2 ? r2[0] : r2[1]; const float rcv = SHFL_XOR(snd, 4); s1 = (b2 ? r2[1] : r2[0]) + rcv; }
        s1 += SHFL_XOR(s1, 8); s1 += SHFL_XOR(s1, 16); s1 += SHFL_XOR(s1, 32);
    }
    s1 *= (1.f / 64.f);
    const float gk = shfl_idx(gi < 8 ? g0 : g1, (gi & 7) * 8 + kperm);
    return gelu_bf(s1) * gk * (1.f / 16.f);
}
__device__ __forceinline__ void peer_accum(const u32x4 (&vw)[8], const float* cfg, f32x2v (&acc2)[8]) {
#pragma unroll
    for (int k = 0; k < 8; ++k) {
        const int src = ((k & 1) << 2) | (k & 2) | ((k >> 2) & 1);
        const float ck = cfg[src];
        const f32x2v ck2 = (f32x2v){ck, ck};
#pragma unroll
        for (int d = 0; d < 4; ++d) {
            const f32x2v lo = __builtin_amdgcn_cvt_pk_f32_fp8((int)vw[k][d], false), hi = __builtin_amdgcn_cvt_pk_f32_fp8((int)vw[k][d], true);
            acc2[2 * d] += ck2 * lo; acc2[2 * d + 1] += ck2 * hi;
        }
    }
}
__device__ __forceinline__ void sort128(unsigned& a0, unsigned& a1, int lane) {
#pragma unroll
    for (int size = 2; size <= 128; size <<= 1) {
#pragma unroll
        for (int stride = size >> 1; stride > 0; stride >>= 1) {
            if (stride == 64) {
                const unsigned lo = a0 < a1 ? a0 : a1, hi = a0 < a1 ? a1 : a0; a0 = lo; a1 = hi;
            } else {
                unsigned p0, p1;
                if (stride == 1) { p0 = (unsigned)dpp_xor1((int)a0); p1 = (unsigned)dpp_xor1((int)a1); }
                else if (stride == 2) { p0 = (unsigned)dpp_xor2((int)a0); p1 = (unsigned)dpp_xor2((int)a1); }
                else if (stride == 8) { p0 = (unsigned)dpp_xor8((int)a0); p1 = (unsigned)dpp_xor8((int)a1); }
                else if (stride == 4) { p0 = (unsigned)dpp_xor4((int)a0, lane); p1 = (unsigned)dpp_xor4((int)a1, lane); }
                else { p0 = (unsigned)__builtin_amdgcn_ds_bpermute((lane ^ stride) << 2, (int)a0); p1 = (unsigned)__builtin_amdgcn_ds_bpermute((lane ^ stride) << 2, (int)a1); }
                const bool lower = (lane & stride) == 0;
                const bool up0 = (size >= 128) ? true : ((lane & size) == 0);
                const bool up1 = (size >= 128) ? true : (size == 64 ? false : ((lane & size) == 0));
                const unsigned mn0 = a0 < p0 ? a0 : p0, mx0 = a0 < p0 ? p0 : a0, mn1 = a1 < p1 ? a1 : p1, mx1 = a1 < p1 ? p1 : a1;
                a0 = (lower == up0) ? mn0 : mx0;
                a1 = (lower == up1) ? mn1 : mx1;
            }
        }
    }
}
__device__ __forceinline__ void phase_peer(const Params& p, int l, float* smemf, const int TID) {
    const int lane = TID & 63, wave = TID >> 6;
    const bf16_t* h2 = (const bf16_t*)(p.ws + OFF_H);
    const unsigned char* pu = p.ws + OFF_PU + (size_t)l * 16384 * D;
    const unsigned char* pv = p.ws + OFF_PV + (size_t)l * 16384 * D;
    const int* eidx = (const int*)(p.ws + OFF_EIDX);
    const float* gate = (const float*)(p.ws + OFF_GATE);
    float* x = (float*)(p.ws + OFF_X);
    bf16_t* hout = (bf16_t*)(p.ws + OFF_H);
    const float* modl = (const float*)(p.ws + OFF_MOD) + (size_t)l * 3 * 6144;
    const int kperm = ((lane & 1) << 2) | (lane & 2) | ((lane >> 2) & 1);
    const int nslot = (T + (int)gridDim.x * 4 - 1) / ((int)gridDim.x * 4);
    float* cfl = smemf + wave * (nslot * 128);
    int* esl = (int*)(smemf + 4 * nslot * 128) + wave * (nslot * 128);
    int slot = 0;
    for (int tok = blockIdx.x * 4 + wave; tok < T; tok += gridDim.x * 4, ++slot) {
        unsigned k0 = ((unsigned)eidx[(size_t)tok * 128 + lane] << 7) | (unsigned)lane, k1 = ((unsigned)eidx[(size_t)tok * 128 + 64 + lane] << 7) | (unsigned)(64 + lane);
        sort128(k0, k1, lane);
        const int e0 = (int)(k0 >> 7), e1 = (int)(k1 >> 7);
        const float g0 = gate[(size_t)tok * 128 + (k0 & 127u)], g1 = gate[(size_t)tok * 128 + (k1 & 127u)];
        esl[slot * 128 + lane] = e0; esl[slot * 128 + 64 + lane] = e1;
        u32x4 ua[8], ub[8];
        peer_load(pu, e0, e1, 0, lane, ua);
        const u32x4 ha = *(const u32x4*)(h2 + (size_t)tok * D + lane * 16), hb = *(const u32x4*)(h2 + (size_t)tok * D + lane * 16 + 8);
        f32x2v hf2[8];
#pragma unroll
        for (int e = 0; e < 4; ++e) { hf2[e] = (f32x2v){bf_lo(ha[e]), bf_hi(ha[e])}; hf2[4 + e] = (f32x2v){bf_lo(hb[e]), bf_hi(hb[e])}; }
#pragma unroll 1
        for (int g2 = 0; g2 < 8; ++g2) {
            peer_load(pu, e0, e1, 2 * g2 + 1, lane, ub);
            const float c0 = peer_dots(ua, hf2, g0, g1, 2 * g2, lane, kperm);
            if (lane < 8) cfl[(slot * 16 + 2 * g2) * 8 + lane] = c0;
            if (g2 < 7) peer_load(pu, e0, e1, 2 * g2 + 2, lane, ua);
            const float c1 = peer_dots(ub, hf2, g0, g1, 2 * g2 + 1, lane, kperm);
            if (lane < 8) cfl[(slot * 16 + 2 * g2 + 1) * 8 + lane] = c1;
        }
    }
    __builtin_amdgcn_wave_barrier();
    slot = 0;
    for (int tok = blockIdx.x * 4 + wave; tok < T; tok += gridDim.x * 4, ++slot) {
        const int e0 = esl[slot * 128 + lane], e1 = esl[slot * 128 + 64 + lane];
        u32x4 va[8], vb[8];
        peer_load(pv, e0, e1, 0, lane, va);
        f32x2v acc2[8];
#pragma unroll
        for (int e = 0; e < 8; ++e) acc2[e] = (f32x2v){0.f, 0.f};
#pragma unroll 1
        for (int g2 = 0; g2 < 8; ++g2) {
            peer_load(pv, e0, e1, 2 * g2 + 1, lane, vb);
            peer_accum(va, cfl + (slot * 16 + 2 * g2) * 8, acc2);
            if (g2 < 7) peer_load(pv, e0, e1, 2 * g2 + 2, lane, va);
            peer_accum(vb, cfl + (slot * 16 + 2 * g2 + 1) * 8, acc2);
        }
        float acc[16];
#pragma unroll
        for (int e = 0; e < 8; ++e) { acc[2 * e] = acc2[e].x; acc[2 * e + 1] = acc2[e].y; }
        const int set = tok_set(tok);
        const float* g2p = modl + (size_t)set * 6144 + 5 * 1024;
        float xn[16]; float ss = 0.f;
#pragma unroll
        for (int q4i = 0; q4i < 4; ++q4i) {
            const int n = lane * 16 + q4i * 4, e = q4i * 4;
            const float4 xv = *(const float4*)(x + (size_t)tok * D + n), gv = *(const float4*)(g2p + n);
            xn[e] = xv.x + gv.x * acc[e]; xn[e + 1] = xv.y + gv.y * acc[e + 1]; xn[e + 2] = xv.z + gv.z * acc[e + 2]; xn[e + 3] = xv.w + gv.w * acc[e + 3];
            ss += xn[e] * xn[e] + xn[e + 1] * xn[e + 1] + xn[e + 2] * xn[e + 2] + xn[e + 3] * xn[e + 3];
        }
        ss = wave_sum(ss, lane);
        const float rstd = rsqrtf(ss * (1.f / D) + RMS_EPS);
        const int n0 = lane * 16;
        if (l == 0) {
            const float* gw = p.g_mix + 1024;
            const float* m1 = (const float*)(p.ws + OFF_MOD) + (size_t)(3 + set) * 6144;
            float y[16];
#pragma unroll
            for (int q4i = 0; q4i < 4; ++q4i) {
                const int e = q4i * 4;
                *(float4*)(x + (size_t)tok * D + n0 + e) = make_float4(xn[e], xn[e + 1], xn[e + 2], xn[e + 3]);
                const float4 gg = *(const float4*)(gw + n0 + e), sc = *(const float4*)(m1 + 1024 + n0 + e), sh = *(const float4*)(m1 + n0 + e);
                y[e] = xn[e] * rstd * gg.x * (1.f + sc.x) + sh.x; y[e + 1] = xn[e + 1] * rstd * gg.y * (1.f + sc.y) + sh.y;
                y[e + 2] = xn[e + 2] * rstd * gg.z * (1.f + sc.z) + sh.z; y[e + 3] = xn[e + 3] * rstd * gg.w * (1.f + sc.w) + sh.w;
            }
            u32x4 o0, o1;
            o0.x = pk2(y[0], y[1]); o0.y = pk2(y[2], y[3]); o0.z = pk2(y[4], y[5]); o0.w = pk2(y[6], y[7]);
            o1.x = pk2(y[8], y[9]); o1.y = pk2(y[10], y[11]); o1.z = pk2(y[12], y[13]); o1.w = pk2(y[14], y[15]);
            *(u32x4*)(hout + (size_t)tok * D + n0) = o0; *(u32x4*)(hout + (size_t)tok * D + n0 + 8) = o1;
        } else {
#pragma unroll
            for (int q4i = 0; q4i < 4; ++q4i) {
                const int e = q4i * 4;
                const float4 ga = *(const float4*)(p.g_final + n0 + e);
                *(float4*)(p.out + (size_t)tok * D + n0 + e) = make_float4(xn[e] * rstd * ga.x, xn[e + 1] * rstd * ga.y, xn[e + 2] * rstd * ga.z, xn[e + 3] * rstd * ga.w);
            }
        }
    }
}

__device__ __forceinline__ void run_phase(const Params& p, int ph, unsigned char* smem, const int TID) {
    bf16_t* sm = (bf16_t*)smem;
    if (ph == 0) { phase_setup(p, smem, TID); return; }
    if (ph == 1) { phase_norm(p, p.g_mix, (const float*)(p.ws + OFF_MOD), 0, 1, TID, true); return; }
    const int l = (ph - 2) >> 3, sub = (ph - 2) & 7;
    switch (sub) {
        case 0: phase_g1(p, l, sm, TID); break;
        case 1: phase_mix(p, l, sm, TID); break;
        case 2: phase_f2(p, sm, TID); break;
        case 3: phase_g3(p, l, sm, TID); break;
        case 4: phase_g4(p, l, sm, TID); break;
        case 5: phase_norm(p, p.g_ffn + (size_t)l * 1024, (const float*)(p.ws + OFF_MOD) + (size_t)l * 3 * 6144, 3, 4, TID); break;
        case 6: phase_g5(p, l, sm, TID); break;
        default: phase_peer(p, l, (float*)smem, TID); break;
    }
}

#define XB_TMO      128
#define XB_XCNT(j)  (256  + 64 * (j))
#define XB_XSUB(j)  (1280 + 64 * (j))
#define XB_XGEN(j)  (2304 + 64 * (j))
#define XB_TOP      3328
#define XB_TOPGEN   3392
#define XB_SPIN_CAP (1u << 21)
#define LAS __attribute__((address_space(3)))
__device__ __forceinline__ unsigned xb_ld(unsigned* p)              { return __hip_atomic_load(p, __ATOMIC_RELAXED, __HIP_MEMORY_SCOPE_AGENT); }
__device__ __forceinline__ unsigned xb_add(unsigned* p, unsigned v) { return __hip_atomic_fetch_add(p, v, __ATOMIC_RELAXED, __HIP_MEMORY_SCOPE_AGENT); }
__device__ __forceinline__ unsigned xb_xcc_id() { return (unsigned)__builtin_amdgcn_s_getreg((3 << 11) | 20) & 0xFu; }
#define XB_SPIN(cond, bar) do { unsigned _sp = 0; while (cond) { __builtin_amdgcn_s_sleep(1); \
    if ((++_sp & 255u) == 0u) { if (xb_ld(&(bar)[XB_TMO])) break; if (_sp > XB_SPIN_CAP) { atomicAdd(&(bar)[XB_TMO], 1u); break; } } } } while (0)
struct XcdBarrier { unsigned* bar; unsigned x; volatile LAS unsigned* st; };
__device__ __forceinline__ XcdBarrier xcd_barrier_post(unsigned* bar, volatile LAS unsigned* st) {
    XcdBarrier b; b.bar = bar; b.x = xb_xcc_id(); b.st = st;
    if (threadIdx.x == 0) (void)xb_add(&bar[XB_XCNT(b.x)], 1u);
    return b;
}
__device__ __forceinline__ void xcd_barrier_complete(unsigned* bar, unsigned x, unsigned& nloc, unsigned& nx) {
    const unsigned G = gridDim.x * gridDim.y * gridDim.z;
    unsigned sum, cnt, mine, sp = 0u;
    for (;;) {
        sum = 0u; cnt = 0u; mine = 0u;
#pragma unroll
        for (unsigned j = 0; j < 16; ++j) { const unsigned c = xb_ld(&bar[XB_XCNT(j)]); sum += c; cnt += (c > 0u) ? 1u : 0u; mine = (j == x) ? c : mine; }
        if (sum == G) break;
        __builtin_amdgcn_s_sleep(1);
        if ((++sp & 255u) == 0u) { if (xb_ld(&bar[XB_TMO])) break; if (sp > XB_SPIN_CAP) { atomicAdd(&bar[XB_TMO], 1u); break; } }
    }
    nloc = mine > 0u ? mine : 1u; nx = cnt > 0u ? cnt : 1u;
}
__device__ __forceinline__ void xcd_barrier(const XcdBarrier& b, const int tid) {
    asm volatile("s_waitcnt vmcnt(0)" ::: "memory");
    __syncthreads();
    if (tid == 0) {
        unsigned* bar = b.bar; unsigned bx = b.x; asm volatile("" : "+s"(bx));
        __builtin_amdgcn_s_waitcnt(0);
        unsigned nloc = b.st[0], nx = b.st[1];
        if (nloc == 0u) { xcd_barrier_complete(bar, bx, nloc, nx); b.st[0] = nloc; b.st[1] = nx; }
        const unsigned old = xb_add(&bar[XB_XSUB(bx)], 1u);
        const unsigned gen = old / nloc;
        if (old + 1u == (gen + 1u) * nloc) {
            __builtin_amdgcn_fence(__ATOMIC_RELEASE, "agent");
            asm volatile("s_waitcnt vmcnt(0)" ::: "memory");
            const unsigned og = xb_add(&bar[XB_TOP], 1u);
            const unsigned tg = og / nx;
            if (og + 1u == (tg + 1u) * nx) xb_add(&bar[XB_TOPGEN], 1u);
            else XB_SPIN(xb_ld(&bar[XB_TOPGEN]) == tg, bar);
            __builtin_amdgcn_fence(__ATOMIC_ACQUIRE, "agent");
            xb_add(&bar[XB_XGEN(bx)], 1u);
            asm volatile("s_waitcnt vmcnt(0)" ::: "memory");
        } else {
            XB_SPIN(xb_ld(&bar[XB_XGEN(bx)]) == gen, bar);
            __builtin_amdgcn_fence(__ATOMIC_ACQUIRE, "agent");
            asm volatile("s_waitcnt vmcnt(0)" ::: "memory");
        }
    }
    __syncthreads();
}

template <bool COOP>
__global__ void __launch_bounds__(256, 2) mega(Params p, int ph_lo, int ph_hi) {
    __shared__ __attribute__((aligned(16))) unsigned char smem[SMEM_BYTES];
    __shared__ uint4 xb_words;
    const int wave_s = __builtin_amdgcn_readfirstlane((int)threadIdx.x >> 6);
    XcdBarrier xb{};
    if (COOP) {
        if (threadIdx.x == 0) xb_words = make_uint4(0u, 0u, 0u, 0u);
        __syncthreads();
        xb = xcd_barrier_post((unsigned*)(p.ws + OFF_BAR), (volatile LAS unsigned*)&xb_words);
        if (ph_hi < 0) cg::this_grid().sync();
    }
    for (int ph = ph_lo; ph < ph_hi; ++ph) {
        unsigned zz = 0u; asm volatile("" : "+v"(zz));
        int tid = wave_s * 64 + (int)__builtin_amdgcn_mbcnt_hi(~0u, __builtin_amdgcn_mbcnt_lo(~0u, zz)); asm volatile("" : "+v"(tid));
        Params q = p; asm volatile("" : "+s"(q.ws));
        run_phase(q, ph, smem, tid);
        if (COOP) { if (ph + 1 < ph_hi) xcd_barrier(xb, tid); }
    }
}

extern "C" void kernel_launch(void* const* d_in, const int* in_sizes, int n_in, void* d_out, int out_size, void* d_ws, size_t ws_size, hipStream_t stream) {
    static int grid = 0;
#if MK_COOP
    const void* fn = (const void*)mega<true>;
#else
    const void* fn = (const void*)mega<false>;
#endif
    if (grid == 0) {
        if (n_in != 22 || ws_size < WS_END) { fprintf(stderr, "kernel_launch: need 22 inputs and >= %zu bytes of workspace (got %d, %zu)\n", (size_t)WS_END, n_in, ws_size); grid = -1; return; }
        int dev = 0, cus = 0, per_cu = 0;
        (void)hipGetDevice(&dev);
        (void)hipDeviceGetAttribute(&cus, hipDeviceAttributeMultiprocessorCount, dev);
        if (hipOccupancyMaxActiveBlocksPerMultiprocessor(&per_cu, fn, 256, 0) != hipSuccess || per_cu < 1) { fprintf(stderr, "kernel_launch: occupancy query failed (%d)\n", per_cu); (void)hipGetLastError(); per_cu = 1; }
        if (per_cu > 2) per_cu = 2;
        grid = cus * per_cu;
        fprintf(stderr, "kernel_launch: grid %d (%d CUs x %d), coop %d\n", grid, cus, per_cu, (int)MK_COOP);
    }
    if (grid < 0) return;
    Params p{};
    p.x_prompt = (const float*)d_in[0]; p.x_sample = (const float*)d_in[1]; p.cache_k = (const float*)d_in[2]; p.cache_v = (const float*)d_in[3];
    p.c = (const float*)d_in[4]; p.c_ctx = (const float*)d_in[5]; p.w_in = (const float*)d_in[6]; p.conv_w = (const float*)d_in[7];
    p.w_conv_out = (const float*)d_in[8]; p.rpb = (const float*)d_in[9]; p.w_attn_out = (const float*)d_in[10]; p.w_four_out = (const float*)d_in[11];
    p.w_o = (const float*)d_in[12]; p.g_mix = (const float*)d_in[13]; p.g_ffn = (const float*)d_in[14]; p.w_mod = (const float*)d_in[15];
    p.b_mod = (const float*)d_in[16]; p.w_pq = (const float*)d_in[17]; p.sub_keys = (const float*)d_in[18]; p.peer_u = (const float*)d_in[19];
    p.peer_v = (const float*)d_in[20]; p.g_final = (const float*)d_in[21];
    p.out = (float*)d_out; p.ws = (unsigned char*)d_ws;
#if MK_COOP
    int lo = 0, hi = NPH;
    void* args[] = {&p, &lo, &hi};
    (void)hipMemsetAsync((unsigned char*)d_ws + OFF_BAR, 0, BAR_BYTES, stream);
    hipError_t e = hipLaunchCooperativeKernel(fn, dim3(grid), dim3(256), args, 0, stream);
    if (e != hipSuccess) fprintf(stderr, "cooperative launch failed: %s (grid %d)\n", hipGetErrorString(e), grid);
#else
    for (int ph = 0; ph < NPH; ++ph) {
        hipLaunchKernelGGL(mega<false>, dim3(grid), dim3(256), 0, stream, p, ph, ph + 1);
    }
#endif
}
```
